# Optimizing an MI355X kernel written in HIP

```python
import math
import numpy as np
import jax
import jax.numpy as jnp
from jax import lax

D_MODEL = 2048
BATCH = 4
SEQ = 2048
DEPTH = 4

N_MIXERS = 4
N_HEADS = 16
HEAD_DIM = 128
WIDTH = N_HEADS * HEAD_DIM
N_KV = 4
HPG = N_HEADS // N_KV
KV_WIDTH = N_KV * HEAD_DIM
QBLOCK = 128
REL_BUCKETS = 32
REL_MAX_DIST = 128
CMP_LEN = 32
CMP_STRIDE = 16
SEL_LEN = 64
SEL_TOPK = 8
SEL_QCHUNK = 64
NSA_WINDOW = 512
SWA_WINDOW = 128
FGATE_BIAS_INIT = 2.0
DN_ALPHA = (2 * DEPTH) ** 0.25
DN_BETA = (8 * DEPTH) ** -0.25
LN_EPS = 1e-5
NEG_INF = -1e30
FORCED_SCORE = 1e4

NSA_SPLITS = (WIDTH,) + (KV_WIDTH,) * 6 + (3 * N_HEADS, WIDTH)
SWA_SPLITS = (WIDTH, KV_WIDTH, KV_WIDTH, WIDTH)
SB_SPLITS = (WIDTH, WIDTH, WIDTH, WIDTH)
FOX_SPLITS = (WIDTH, WIDTH, WIDTH, N_HEADS, WIDTH)

kernel_name = 'hybrid_nsa_swa_stickbreaking_fox'


def split_cols(h, sizes):
    cuts = [int(c) for c in np.cumsum(sizes)[:-1]]
    return jnp.split(h, cuts, axis=-1)


def layer_norm(x, g, b):
    xf = x.astype(jnp.float32)
    mu = jnp.mean(xf, axis=-1, keepdims=True)
    var = jnp.mean(jnp.square(xf - mu), axis=-1, keepdims=True)
    return ((xf - mu) * lax.rsqrt(var + LN_EPS) * g + b).astype(x.dtype)


def rel_bucket(dist):
    dist = jnp.maximum(dist, 0)
    max_exact = REL_BUCKETS // 2
    ratio = jnp.maximum(dist, max_exact).astype(jnp.float32) / max_exact
    large = max_exact + (jnp.log(ratio) / math.log(REL_MAX_DIST / max_exact)
                         * (REL_BUCKETS - max_exact)).astype(jnp.int32)
    return jnp.where(dist < max_exact, dist, jnp.minimum(large, REL_BUCKETS - 1))


def masked_softmax(s, mask, sink=None):
    s = jnp.where(mask, s, NEG_INF)
    m = jnp.max(s, axis=-1, keepdims=True)
    if sink is not None:
        m = jnp.maximum(m, sink)
    p = jnp.where(mask, jnp.exp(s - m), 0.0)
    den = jnp.sum(p, axis=-1, keepdims=True)
    if sink is not None:
        den = den + jnp.exp(sink - m)
    return p / jnp.maximum(den, 1e-30)


def banded_gqa(q, k, v, window, rel_bias, sinks=None):
    b, s_len = q.shape[:2]
    nq = s_len // QBLOCK
    kw = QBLOCK + window
    pad = ((0, 0), (window, 0), (0, 0), (0, 0))
    idx = np.arange(nq)[:, None] * QBLOCK + np.arange(kw)[None, :]
    kb = jnp.pad(k, pad)[:, idx]
    vb = jnp.pad(v, pad)[:, idx]
    qr = q.reshape(b, nq, QBLOCK, N_KV, HPG, HEAD_DIM)
    s = jnp.einsum('bnqgrd,bnkgd->bngrqk', qr, kb).astype(jnp.float32) * HEAD_DIM ** -0.5
    qpos = np.arange(nq)[:, None] * QBLOCK + np.arange(QBLOCK)[None, :]
    kpos = idx - window
    dist = (qpos[:, :, None] - kpos[:, None, :]).astype(np.int32)
    mask = (dist >= 0) & (dist < window) & (kpos[:, None, :] >= 0)
    bias = rel_bias[rel_bucket(jnp.asarray(dist))]
    bias = bias.reshape(nq, QBLOCK, kw, N_KV, HPG).transpose(0, 3, 4, 1, 2)
    s = s + bias[None].astype(jnp.float32)
    mask = jnp.asarray(mask)[None, :, None, None]
    sink = None if sinks is None else sinks.astype(jnp.float32).reshape(1, 1, N_KV, HPG, 1, 1)
    p = masked_softmax(s, mask, sink)
    o = jnp.einsum('bngrqk,bnkgd->bnqgrd', p.astype(v.dtype), vb)
    return o.reshape(b, s_len, N_HEADS, HEAD_DIM)


def nsa_compress(kv, pe, w1, w2):
    n_cmp = (kv.shape[1] - CMP_LEN) // CMP_STRIDE + 1
    idx = np.arange(n_cmp)[:, None] * CMP_STRIDE + np.arange(CMP_LEN)[None, :]
    blocks = kv[:, idx] + pe[None, None, :, None, :]
    hid = jax.nn.silu(jnp.einsum('bnlgd,lde->bnge', blocks, w1))
    return jnp.einsum('bnge,ef->bngf', hid, w2)


def mixer_nsa(h, rel_bias, cmp_pe_k, cmp_w1_k, cmp_w2_k, cmp_pe_v, cmp_w1_v, cmp_w2_v):
    b, s_len = h.shape[:2]
    q, kc, vc, ks, vs, kw, vw, gl, z = split_cols(h, NSA_SPLITS)
    q = q.reshape(b, s_len, N_KV, HPG, HEAD_DIM)

    def kvh(t):
        return t.reshape(b, s_len, N_KV, HEAD_DIM)

    scale = HEAD_DIM ** -0.5
    pos = np.arange(s_len)

    k_cmp = nsa_compress(kvh(kc), cmp_pe_k, cmp_w1_k, cmp_w2_k)
    v_cmp = nsa_compress(kvh(vc), cmp_pe_v, cmp_w1_v, cmp_w2_v)
    n_cmp = k_cmp.shape[1]
    blk_end = np.arange(n_cmp) * CMP_STRIDE + CMP_LEN - 1
    dist_c = (pos[:, None] - blk_end[None, :]).astype(np.int32)
    bias_c = rel_bias[rel_bucket(jnp.asarray(dist_c))].reshape(s_len, n_cmp, N_KV, HPG)
    s_c = (jnp.einsum('bsgrd,bngd->bgrsn', q, k_cmp).astype(jnp.float32) * scale
           + bias_c.transpose(2, 3, 0, 1)[None].astype(jnp.float32))
    p_c = masked_softmax(s_c, jnp.asarray(dist_c >= 0)[None, None, None])
    o_cmp = jnp.einsum('bgrsn,bngd->bsgrd', p_c.astype(v_cmp.dtype), v_cmp)
    o_cmp = o_cmp.reshape(b, s_len, N_HEADS, HEAD_DIM)

    nb = s_len // SEL_LEN
    cstart = np.arange(n_cmp) * CMP_STRIDE
    sstart = np.arange(nb) * SEL_LEN
    inter = np.clip(np.minimum(cstart[:, None] + CMP_LEN, sstart[None, :] + SEL_LEN)
                    - np.maximum(cstart[:, None], sstart[None, :]), 0, None) / CMP_LEN
    imp = jnp.einsum('bgrsn,nj->bgsj', p_c, jnp.asarray(inter, jnp.float32))
    blk = np.arange(nb)
    cur = pos // SEL_LEN
    allowed = blk[None, :] * SEL_LEN <= pos[:, None]
    forced = (blk[None, :] == 0) | (blk[None, :] == cur[:, None]) | (blk[None, :] == cur[:, None] - 1)
    imp = jnp.where(jnp.asarray(forced & allowed), FORCED_SCORE,
                    jnp.where(jnp.asarray(allowed), imp, NEG_INF))
    n_pad = max(nb, SEL_TOPK) - nb
    imp = jnp.pad(imp, ((0, 0), (0, 0), (0, 0), (0, n_pad)), constant_values=NEG_INF)
    top_val, top_idx = lax.top_k(imp, SEL_TOPK)
    blk_ok = top_val > NEG_INF / 2
    top_idx = jnp.minimum(top_idx, nb - 1)

    ks_blocks = kvh(ks).reshape(b, nb, SEL_LEN, N_KV, HEAD_DIM).transpose(0, 3, 1, 2, 4)
    vs_blocks = kvh(vs).reshape(b, nb, SEL_LEN, N_KV, HEAD_DIM).transpose(0, 3, 1, 2, 4)
    nc = s_len // SEL_QCHUNK
    q_chunks = q.reshape(b, nc, SEL_QCHUNK, N_KV, HPG, HEAD_DIM).transpose(1, 0, 2, 3, 4, 5)
    idx_chunks = top_idx.reshape(b, N_KV, nc, SEL_QCHUNK, SEL_TOPK).transpose(2, 0, 1, 3, 4)
    ok_chunks = blk_ok.reshape(b, N_KV, nc, SEL_QCHUNK, SEL_TOPK).transpose(2, 0, 1, 3, 4)
    pos_chunks = jnp.arange(s_len, dtype=jnp.int32).reshape(nc, SEL_QCHUNK)
    bi = jnp.arange(b)[:, None, None, None]
    gi = jnp.arange(N_KV)[None, :, None, None]
    tbl = rel_bias.reshape(REL_BUCKETS, N_KV, HPG).transpose(1, 0, 2)

    def sel_chunk(args):
        qc, ic, okc, tc = args
        kg = ks_blocks[bi, gi, ic].reshape(b, N_KV, SEL_QCHUNK, SEL_TOPK * SEL_LEN, HEAD_DIM)
        vg = vs_blocks[bi, gi, ic].reshape(b, N_KV, SEL_QCHUNK, SEL_TOPK * SEL_LEN, HEAD_DIM)
        kpos = (ic[..., None] * SEL_LEN + jnp.arange(SEL_LEN, dtype=jnp.int32)).reshape(
            b, N_KV, SEL_QCHUNK, SEL_TOPK * SEL_LEN)
        dist = tc[None, None, :, None] - kpos
        mask = jnp.repeat(okc, SEL_LEN, axis=-1) & (dist >= 0)
        bias = tbl[gi, rel_bucket(dist)].transpose(0, 1, 4, 2, 3)
        s = jnp.einsum('bqgrd,bgqkd->bgrqk', qc, kg).astype(jnp.float32) * scale + bias.astype(jnp.float32)
        p = masked_softmax(s, mask[:, :, None])
        return jnp.einsum('bgrqk,bgqkd->bqgrd', p.astype(vg.dtype), vg)

    o_sel = lax.map(sel_chunk, (q_chunks, idx_chunks, ok_chunks, pos_chunks))
    o_sel = o_sel.transpose(1, 0, 2, 3, 4, 5).reshape(b, s_len, N_HEADS, HEAD_DIM)

    o_win = banded_gqa(q.reshape(b, s_len, N_HEADS, HEAD_DIM), kvh(kw), kvh(vw), NSA_WINDOW, rel_bias)

    g = jax.nn.sigmoid(gl.astype(jnp.float32)).reshape(b, s_len, N_HEADS, 3).astype(o_win.dtype)
    o = g[..., 0:1] * o_cmp + g[..., 1:2] * o_sel + g[..., 2:3] * o_win
    return o.reshape(b, s_len, WIDTH), z


def mixer_swa_sinks(h, rel_bias, sinks):
    b, s_len = h.shape[:2]
    q, k, v, z = split_cols(h, SWA_SPLITS)
    o = banded_gqa(q.reshape(b, s_len, N_HEADS, HEAD_DIM),
                   k.reshape(b, s_len, N_KV, HEAD_DIM),
                   v.reshape(b, s_len, N_KV, HEAD_DIM),
                   SWA_WINDOW, rel_bias, sinks)
    return o.reshape(b, s_len, WIDTH), z


def mixer_stick_breaking(h):
    b, s_len = h.shape[:2]
    q, k, v, z = split_cols(h, SB_SPLITS)
    q, k, v = (t.reshape(b, s_len, N_HEADS, HEAD_DIM) for t in (q, k, v))
    scale = HEAD_DIM ** -0.5
    outs = []
    for i in range(s_len // QBLOCK):
        lo, hi = i * QBLOCK, (i + 1) * QBLOCK
        zl = jnp.einsum('bqhd,bkhd->bhqk', q[:, lo:hi], k[:, :hi]).astype(jnp.float32) * scale
        strict = jnp.asarray(np.arange(hi)[None, :] < np.arange(lo, hi)[:, None])
        log_keep = jnp.where(strict, jax.nn.log_sigmoid(-zl), 0.0)
        after = lax.cumsum(log_keep, axis=3, reverse=True) - log_keep
        a = jnp.where(strict, jnp.exp(jax.nn.log_sigmoid(zl) + after), 0.0)
        outs.append(jnp.einsum('bhqk,bkhd->bqhd', a.astype(v.dtype), v[:, :hi]))
    o = jnp.concatenate(outs, axis=1)
    return o.reshape(b, s_len, WIDTH), z


def mixer_forgetting(h, fgate_bias):
    b, s_len = h.shape[:2]
    q, k, v, fl, z = split_cols(h, FOX_SPLITS)
    q, k, v = (t.reshape(b, s_len, N_HEADS, HEAD_DIM) for t in (q, k, v))
    log_f = jax.nn.log_sigmoid((fl + fgate_bias).astype(jnp.float32))
    c = jnp.cumsum(log_f, axis=1).transpose(0, 2, 1)
    scale = HEAD_DIM ** -0.5
    outs = []
    for i in range(s_len // QBLOCK):
        lo, hi = i * QBLOCK, (i + 1) * QBLOCK
        s = (jnp.einsum('bqhd,bkhd->bhqk', q[:, lo:hi], k[:, :hi]).astype(jnp.float32) * scale
             + c[:, :, lo:hi, None] - c[:, :, None, :hi])
        causal = jnp.asarray(np.arange(hi)[None, :] <= np.arange(lo, hi)[:, None])
        p = masked_softmax(s, causal)
        outs.append(jnp.einsum('bhqk,bkhd->bqhd', p.astype(v.dtype), v[:, :hi]))
    o = jnp.concatenate(outs, axis=1)
    return o.reshape(b, s_len, WIDTH), z


def setup_inputs(seed: int = 0) -> dict:
    key = jax.random.key(seed)
    keys = jax.random.split(key, 32)
    count = [0]

    def normal(shape, scale):
        k = keys[count[0]]
        count[0] += 1
        return jax.random.normal(k, shape, jnp.float32) * scale

    w_in_scale = D_MODEL ** -0.5
    w_out_scale = DN_BETA * WIDTH ** -0.5
    inp = {}
    inp['x'] = normal((BATCH, SEQ, D_MODEL), 1.0)
    inp['rel_bias'] = normal((REL_BUCKETS, N_HEADS), 0.5)
    inp['w_in_a'] = normal((D_MODEL, sum(NSA_SPLITS)), w_in_scale)
    inp['w_out_a'] = normal((WIDTH, D_MODEL), w_out_scale)
    inp['ln_g_a'] = 1.0 + normal((D_MODEL,), 0.02)
    inp['ln_b_a'] = normal((D_MODEL,), 0.02)
    inp['cmp_pe_k'] = normal((CMP_LEN, HEAD_DIM), 0.5)
    inp['cmp_w1_k'] = normal((CMP_LEN, HEAD_DIM, HEAD_DIM), (CMP_LEN * HEAD_DIM) ** -0.5)
    inp['cmp_w2_k'] = normal((HEAD_DIM, HEAD_DIM), HEAD_DIM ** -0.5)
    inp['cmp_pe_v'] = normal((CMP_LEN, HEAD_DIM), 0.5)
    inp['cmp_w1_v'] = normal((CMP_LEN, HEAD_DIM, HEAD_DIM), (CMP_LEN * HEAD_DIM) ** -0.5)
    inp['cmp_w2_v'] = normal((HEAD_DIM, HEAD_DIM), HEAD_DIM ** -0.5)
    inp['w_in_b'] = normal((D_MODEL, sum(SWA_SPLITS)), w_in_scale)
    inp['w_out_b'] = normal((WIDTH, D_MODEL), w_out_scale)
    inp['ln_g_b'] = 1.0 + normal((D_MODEL,), 0.02)
    inp['ln_b_b'] = normal((D_MODEL,), 0.02)
    inp['sinks_b'] = normal((N_HEADS,), 0.5)
    inp['w_in_c'] = normal((D_MODEL, sum(SB_SPLITS)), w_in_scale)
    inp['w_out_c'] = normal((WIDTH, D_MODEL), w_out_scale)
    inp['ln_g_c'] = 1.0 + normal((D_MODEL,), 0.02)
    inp['ln_b_c'] = normal((D_MODEL,), 0.02)
    inp['w_in_d'] = normal((D_MODEL, sum(FOX_SPLITS)), w_in_scale)
    inp['w_out_d'] = normal((WIDTH, D_MODEL), w_out_scale)
    inp['ln_g_d'] = 1.0 + normal((D_MODEL,), 0.02)
    inp['ln_b_d'] = normal((D_MODEL,), 0.02)
    inp['fgate_bias_d'] = FGATE_BIAS_INIT + normal((N_HEADS,), 0.5)
    return inp


def reference(x, rel_bias,
              w_in_a, w_out_a, ln_g_a, ln_b_a,
              cmp_pe_k, cmp_w1_k, cmp_w2_k, cmp_pe_v, cmp_w1_v, cmp_w2_v,
              w_in_b, w_out_b, ln_g_b, ln_b_b, sinks_b,
              w_in_c, w_out_c, ln_g_c, ln_b_c,
              w_in_d, w_out_d, ln_g_d, ln_b_d, fgate_bias_d):
    mixers = (
        lambda h: mixer_nsa(h, rel_bias, cmp_pe_k, cmp_w1_k, cmp_w2_k, cmp_pe_v, cmp_w1_v, cmp_w2_v),
        lambda h: mixer_swa_sinks(h, rel_bias, sinks_b),
        mixer_stick_breaking,
        lambda h: mixer_forgetting(h, fgate_bias_d),
    )
    w_in = (w_in_a, w_in_b, w_in_c, w_in_d)
    w_out = (w_out_a, w_out_b, w_out_c, w_out_d)
    ln_g = (ln_g_a, ln_g_b, ln_g_c, ln_g_d)
    ln_b = (ln_b_a, ln_b_b, ln_b_c, ln_b_d)
    for i in range(DEPTH):
        m = i % N_MIXERS
        h = x @ w_in[m]
        o, z = mixers[m](h)
        y = (o * jax.nn.silu(z)) @ w_out[m]
        x = layer_norm(DN_ALPHA * x + y, ln_g[m], ln_b[m])
    return x
```

```cpp
#include <hip/hip_runtime.h>
#include <hip/hip_cooperative_groups.h>
#include <cstdio>
#include <cstdint>
namespace cg = cooperative_groups;
namespace pg8 {
#define PG8_LAS __attribute__((address_space(3)))
typedef unsigned short bf16_t;
typedef short bf16x8 __attribute__((ext_vector_type(8)));
typedef float f32x4 __attribute__((ext_vector_type(4)));
typedef unsigned u32x4 __attribute__((ext_vector_type(4)));
constexpr int BM = 256, BK = 64, HALF = 128, HTB = HALF * BK * 2  , STAGE_BYTES = 8 * HTB, NXCD = 8, WGM = 8;

__host__ __device__ __forceinline__ int lds_byte(int r, int c) { const int st = (r >> 4) * 2 + (c >> 5), rr = r & 15, cc = c & 31, ob = rr * 64 + cc * 2; return st * 1024 + (ob ^ (((ob >> 9) & 1) << 5)); }
__host__ __device__ __forceinline__ void stage_rc(int b, int& R, int& C) { const int st = b / 1024, sb = b % 1024, swz = sb ^ (((sb >> 9) & 1) << 5); R = (st >> 1) * 16 + swz / 64; C = (st & 1) * 32 + (swz % 64) / 2; }
__host__ __device__ __forceinline__ int perm32(int rho) { const int n = rho >> 4, i = rho & 15; return 8 * (i >> 2) + 4 * n + (i & 3); }

struct Unit { int pm, pn; };
struct Gemm { const bf16_t* A; const bf16_t* Bt; int M, N, K; };

struct StaticOrder {
    int nM, nN, nwg, G, c;
    __host__ __device__ void init(int M, int N, int G_, int c_) { nM = M / BM; nN = N / BM; nwg = nM * nN; G = G_; c = c_; }
    __host__ __device__ bool next(int i, Unit& u) const {
        const long L = (long)i * G + c; if (L >= nwg) return false;
        int wgid = (int)L; { const int q = nwg / NXCD, r = nwg % NXCD, xcd = wgid % NXCD, off = wgid / NXCD; wgid = (xcd < r ? xcd * (q + 1) : r * (q + 1) + (xcd - r) * q) + off; }
        const int nig = WGM * nN, gid = wgid / nig, fm = gid * WGM, gsz = (nM - fm) < WGM ? (nM - fm) : WGM;
        u.pm = fm + ((wgid % nig) % gsz); u.pn = (wgid % nig) / gsz; return true;
    }
    __device__ __forceinline__ void a_ready(const Unit&) const {}
    __device__ __forceinline__ void done(const Unit&) const {}
};
__device__ __forceinline__ unsigned cvt_pk_bf16(float lo, float hi) { unsigned r; asm volatile("v_cvt_pk_bf16_f32 %0, %1, %2" : "=v"(r) : "v"(lo), "v"(hi)); return r; }
typedef float f32x2 __attribute__((ext_vector_type(2)));
typedef float f32x2 __attribute__((ext_vector_type(2)));
struct EpiH {
    static constexpr bool PERM = true, AFTER_DRAIN = false;
    bf16_t* O; int ldc;
    __device__ __forceinline__ void operator()(const f32x4 (&acc)[2][2][4][2], const Unit& u, int wr, int wc, int fr, int fq) const {
        const int row0 = u.pm * BM + wr * 64 + fr, col0 = u.pn * BM + wc * 32 + 8 * fq;
#pragma unroll
        for (int ai = 0; ai < 2; ++ai)
#pragma unroll
            for (int m = 0; m < 4; ++m) { bf16_t* rowp = O + (size_t)(row0 + ai * HALF + m * 16) * ldc + col0;
#pragma unroll
                for (int bj = 0; bj < 2; ++bj) { const f32x4 v0 = acc[ai][bj][m][0], v1 = acc[ai][bj][m][1];
                    u32x4 w; w.x = cvt_pk_bf16(v0[0], v0[1]); w.y = cvt_pk_bf16(v0[2], v0[3]); w.z = cvt_pk_bf16(v1[0], v1[1]); w.w = cvt_pk_bf16(v1[2], v1[3]);
                    *(u32x4*)(rowp + bj * HALF) = w; } }
    }
};
struct EpiRes {
    static constexpr bool PERM = false, AFTER_DRAIN = false;
    float* C; const float* R; int ldc; float alpha;
    __device__ __forceinline__ void operator()(const f32x4 (&acc)[2][2][4][2], const Unit& u, int wr, int wc, int fr, int fq) const {
        const int row0 = u.pm * BM + wr * 64 + fr, col0 = u.pn * BM + wc * 32 + 4 * fq;
#pragma unroll
        for (int ai = 0; ai < 2; ++ai)
#pragma unroll
            for (int m = 0; m < 4; ++m) { const size_t off = (size_t)(row0 + ai * HALF + m * 16) * ldc + col0;
#pragma unroll
                for (int bj = 0; bj < 2; ++bj)
#pragma unroll
                    for (int n = 0; n < 2; ++n) { const f32x4 r = *(const f32x4*)(R + off + bj * HALF + n * 16); *(f32x4*)(C + off + bj * HALF + n * 16) = acc[ai][bj][m][n] + alpha * r; }
                asm volatile("" ::: "memory"); }
    }
};
template <class Epi, class Sched, bool STAMP = false>
__device__ __forceinline__ void gemm_phase(PG8_LAS unsigned char* lds, const Gemm g, const Sched& S, const Epi& E, unsigned long long* stamps) {
    const int tid = threadIdx.x, wid = __builtin_amdgcn_readfirstlane(tid >> 6), lane = tid & 63, wr = wid >> 2, wc = wid & 3, fr = lane & 15, fq = lane >> 4;
    const int K = g.K, nt = K / BK;
    int ts_lo = 0, ts_hi = 0, nts = 0; const unsigned long long rt_entry = STAMP ? (unsigned long long)wall_clock64() : 0ull;
#define PG8_STAMP() do { if (STAMP && wid == 0 && nts < 64) { const unsigned long long _c = (unsigned long long)clock64(); \
        ts_lo = (lane == nts) ? (int)(unsigned)_c : ts_lo; ts_hi = (lane == nts) ? (int)(unsigned)(_c >> 32) : ts_hi; ++nts; } } while (0)
    PG8_STAMP();
    unsigned voffA[2], voffB[2];
#pragma unroll
    for (int i = 0; i < 2; ++i) { int R, C; stage_rc(tid * 16 + i * 8192, R, C); const int Rb = Epi::PERM ? ((R & ~31) + perm32(R & 31)) : R;
        voffA[i] = (unsigned)(R * K + C) * 2u; voffB[i] = (unsigned)(Rb * K + C) * 2u; }
    const size_t kstep = (size_t)(BK * 2);
    const size_t hstep = (size_t)HALF * K * 2;
    const size_t tstep = 2 * hstep;
    const unsigned ldsw = (unsigned)wid * 1024u;
    const int aoff = lds_byte(wr * 64 + fr, fq * 8), boff = lds_byte(wc * 32 + fr, fq * 8);
#define PG8_SA(b, h) (((b) * 2 + (h)) * HTB)
#define PG8_SB(b, h) ((4 + (b) * 2 + (h)) * HTB)
#define PG8_STAGE(bufoff, gbase, voff) do { _Pragma("unroll") for (int _i = 0; _i < 2; ++_i) \
        __builtin_amdgcn_global_load_lds((const unsigned*)((const char*)(gbase) + (voff)[_i]), (PG8_LAS unsigned*)(lds + (bufoff) + ldsw + _i * 8192), 16, 0, 0); } while (0)
#define PG8_LDA(dst, b, h) do { _Pragma("unroll") for (int m = 0; m < 4; ++m) _Pragma("unroll") for (int k = 0; k < 2; ++k) dst[m][k] = *(const PG8_LAS bf16x8*)(lds + PG8_SA(b, h) + aoff + m * 2048 + k * 1024); } while (0)
#define PG8_LDB(dst, b, h) do { _Pragma("unroll") for (int n = 0; n < 2; ++n) _Pragma("unroll") for (int k = 0; k < 2; ++k) dst[n][k] = *(const PG8_LAS bf16x8*)(lds + PG8_SB(b, h) + boff + n * 2048 + k * 1024); } while (0)
#define PG8_MMA(ai, bj, At, Bt) do { __builtin_amdgcn_s_setprio(1); _Pragma("unroll") for (int m = 0; m < 4; ++m) _Pragma("unroll") for (int n = 0; n < 2; ++n) _Pragma("unroll") for (int k = 0; k < 2; ++k) \
        acc[ai][bj][m][n] = __builtin_amdgcn_mfma_f32_16x16x32_bf16(Bt[n][k], At[m][k], acc[ai][bj][m][n], 0, 0, 0); __builtin_amdgcn_s_setprio(0); } while (0)
#define PG8_WAIT_V(n) asm volatile("s_waitcnt vmcnt(" #n ")" ::: "memory")
#define PG8_WAIT_L(n) asm volatile("s_waitcnt lgkmcnt(" #n ")" ::: "memory")
#define PG8_BAR __builtin_amdgcn_s_barrier()
#define PG8_SCHED __builtin_amdgcn_sched_barrier(0)
    Unit cur, nxt; int ui = 0;
    if (!S.next(0, cur)) return;
    f32x4 acc[2][2][4][2];
#pragma unroll
    for (int a = 0; a < 2; ++a)
#pragma unroll
        for (int b = 0; b < 2; ++b)
#pragma unroll
            for (int m = 0; m < 4; ++m)
#pragma unroll
                for (int n = 0; n < 2; ++n) acc[a][b][m][n] = (f32x4){0.f, 0.f, 0.f, 0.f};
    bf16x8 At[4][2], B0[2][2], B1[2][2];
    const char* cA = (const char*)g.A + (size_t)cur.pm * tstep; const char* cB = (const char*)g.Bt + (size_t)cur.pn * tstep;
    S.a_ready(cur);
    PG8_STAGE(PG8_SB(0, 0), cB, voffB); PG8_STAGE(PG8_SA(0, 0), cA, voffA); PG8_STAGE(PG8_SB(0, 1), cB + hstep, voffB); PG8_STAGE(PG8_SA(0, 1), cA + hstep, voffA);
    if (wr == 1) PG8_BAR;
    PG8_WAIT_V(4); PG8_BAR;
    PG8_STAGE(PG8_SB(1, 0), cB + kstep, voffB); PG8_STAGE(PG8_SA(1, 0), cA + kstep, voffA); PG8_STAGE(PG8_SB(1, 1), cB + hstep + kstep, voffB);
    PG8_WAIT_V(6); PG8_BAR;
    PG8_STAMP();
    for (;;) {
        const bool has_next = S.next(ui + 1, nxt);
        const char* nA = has_next ? (const char*)g.A + (size_t)nxt.pm * tstep : cA; const char* nB = has_next ? (const char*)g.Bt + (size_t)nxt.pn * tstep : cB;
        for (int t = 0; t < nt; t += 2) {
            const bool last = (t == nt - 2);
            const char* a1 = cA + (size_t)(t + 1) * kstep;
            const char* a2 = last ? nA : cA + (size_t)(t + 2) * kstep; const char* b2 = last ? nB : cB + (size_t)(t + 2) * kstep;
            const char* a3 = a2 + kstep; const char* b3 = b2 + kstep;
            if (last && has_next) S.a_ready(nxt);
            PG8_LDB(B0, 0, 0); PG8_SCHED; PG8_LDA(At, 0, 0); PG8_STAGE(PG8_SA(1, 1), a1 + hstep, voffA);
            PG8_WAIT_L(8); PG8_BAR; PG8_WAIT_L(0); PG8_MMA(0, 0, At, B0); PG8_BAR; PG8_SCHED;
            PG8_LDB(B1, 0, 1); PG8_STAGE(PG8_SB(0, 0), b2, voffB);
            PG8_BAR; PG8_WAIT_L(0); PG8_MMA(0, 1, At, B1); PG8_BAR;
            PG8_LDA(At, 0, 1); PG8_STAGE(PG8_SA(0, 0), a2, voffA);
            PG8_BAR; PG8_WAIT_L(0); PG8_MMA(1, 0, At, B0); PG8_BAR; PG8_SCHED;
            PG8_STAGE(PG8_SB(0, 1), b2 + hstep, voffB);
            PG8_WAIT_V(6); PG8_BAR; PG8_MMA(1, 1, At, B1); PG8_BAR;
            PG8_LDB(B0, 1, 0); PG8_SCHED; PG8_LDA(At, 1, 0); PG8_STAGE(PG8_SA(0, 1), a2 + hstep, voffA);
            PG8_WAIT_L(8); PG8_BAR; PG8_WAIT_L(0); PG8_MMA(0, 0, At, B0); PG8_BAR; PG8_SCHED;
            PG8_LDB(B1, 1, 1); PG8_STAGE(PG8_SB(1, 0), b3, voffB);
            PG8_BAR; PG8_WAIT_L(0); PG8_MMA(0, 1, At, B1); PG8_BAR;
            PG8_LDA(At, 1, 1); PG8_STAGE(PG8_SA(1, 0), a3, voffA);
            PG8_BAR; PG8_WAIT_L(0); PG8_MMA(1, 0, At, B0); PG8_BAR; PG8_SCHED;
            PG8_STAGE(PG8_SB(1, 1), b3 + hstep, voffB);
            PG8_WAIT_V(6); PG8_BAR; PG8_MMA(1, 1, At, B1); PG8_BAR;
        }
        PG8_STAMP();
        if constexpr (!Epi::AFTER_DRAIN) { E(acc, cur, wr, wc, fr, fq); S.done(cur); }
        PG8_STAMP();
        if (!has_next) break;
#pragma unroll
        for (int a = 0; a < 2; ++a)
#pragma unroll
            for (int b = 0; b < 2; ++b)
#pragma unroll
                for (int m = 0; m < 4; ++m)
#pragma unroll
                    for (int n = 0; n < 2; ++n) acc[a][b][m][n] = (f32x4){0.f, 0.f, 0.f, 0.f};
        cur = nxt; cA = nA; cB = nB; ++ui;
    }
    PG8_WAIT_V(0);
    if (wr == 0) PG8_BAR;
    PG8_BAR;
    if constexpr (Epi::AFTER_DRAIN) { E.fused(acc, cur, wr, wc, fr, fq, lds, wid, lane); S.done(cur); }
    PG8_STAMP();
    if (STAMP && wid == 0) { stamps[lane] = lane < nts ? (((unsigned long long)(unsigned)ts_hi << 32) | (unsigned)ts_lo) : 0ull;
        if (lane == 62) stamps[62] = rt_entry; if (lane == 63) stamps[63] = (unsigned long long)wall_clock64(); }
#undef PG8_STAMP
#undef PG8_SA
#undef PG8_SB
#undef PG8_STAGE
#undef PG8_LDA
#undef PG8_LDB
#undef PG8_MMA
#undef PG8_WAIT_V
#undef PG8_WAIT_L
#undef PG8_BAR
#undef PG8_SCHED
}
}
typedef unsigned short bf16_t;
typedef short bf16x8 __attribute__((ext_vector_type(8)));
typedef float f32x4 __attribute__((ext_vector_type(4)));
typedef float f32x16 __attribute__((ext_vector_type(16)));
typedef unsigned u32x4 __attribute__((ext_vector_type(4)));
typedef unsigned u32x2 __attribute__((ext_vector_type(2)));
#define LAS __attribute__((address_space(3)))

constexpr int Bz = 4, S = 2048, DM = 2048, M = Bz * S, NH = 16, HD = 128, NKV = 4, WIDTH = 2048;
constexpr int NCMP = 127;
constexpr float SCALE = 0.08838834764831845f;
constexpr float DN_ALPHA = 1.6817928305074292f;
constexpr float LN_EPS = 1e-5f;
constexpr float NEG_INF = -1e30f;
__device__ __constant__ int LDH_[4] = {7168, 5120, 8192, 8192};

constexpr size_t al256(size_t x) { return (x + 255) & ~(size_t)255; }
constexpr size_t WS_WTIN0 = 0;
constexpr size_t WS_WTIN1 = WS_WTIN0 + (size_t)7168 * 2048 * 2;
constexpr size_t WS_WTIN2 = WS_WTIN1 + (size_t)5120 * 2048 * 2;
constexpr size_t WS_WTIN3 = WS_WTIN2 + (size_t)8192 * 2048 * 2;
constexpr size_t WS_WTOUT = WS_WTIN3 + (size_t)8192 * 2048 * 2;
constexpr size_t WS_WTSK  = WS_WTOUT + (size_t)4 * 2048 * 2048 * 2;
constexpr size_t WS_W1T   = WS_WTSK + (size_t)64 * 2048 * 2;
constexpr size_t WS_W2T   = WS_W1T + (size_t)2 * 128 * 4096 * 2;
constexpr size_t WS_C1    = WS_W2T + (size_t)2 * 128 * 128 * 2;
constexpr size_t WS_H     = al256(WS_C1 + 2 * 128 * 4);
constexpr size_t WS_XB    = WS_H + (size_t)M * 8192 * 2;
constexpr size_t WS_U     = WS_XB + (size_t)M * DM * 2;
constexpr size_t WS_GL    = WS_U + (size_t)M * WIDTH * 2;
constexpr size_t WS_FL    = WS_GL + (size_t)M * 48 * 4;
constexpr size_t WS_CF    = WS_FL + (size_t)M * 16 * 4;
constexpr size_t WS_KCMP  = WS_CF + (size_t)M * 16 * 4;
constexpr size_t WS_VCMP  = WS_KCMP + (size_t)Bz * 4 * 128 * 128 * 2;
constexpr size_t WS_SELM  = WS_VCMP + (size_t)Bz * 4 * 128 * 128 * 2;
constexpr size_t WS_END   = WS_SELM + (size_t)M * 4 * 4;

struct Args { const float* in[26]; float* out; unsigned char* ws; int ph_lo, ph_hi; };
static_assert(sizeof(Args) == 26 * 8 + 8 + 8 + 8, "no padding");

enum { I_X = 0, I_RELB = 1, I_WINA = 2, I_WOUTA = 3, I_LNGA = 4, I_LNBA = 5, I_PEK = 6, I_W1K = 7, I_W2K = 8, I_PEV = 9, I_W1V = 10, I_W2V = 11,
       I_WINB = 12, I_WOUTB = 13, I_LNGB = 14, I_LNBB = 15, I_SINKS = 16, I_WINC = 17, I_WOUTC = 18, I_LNGC = 19, I_LNBC = 20,
       I_WIND = 21, I_WOUTD = 22, I_LNGD = 23, I_LNBD = 24, I_FGB = 25 };

constexpr int LDS_MAIN = 131072, LDS_MISC = 8192, LDS_BYTES = LDS_MAIN + LDS_MISC;

__device__ __forceinline__ const float* gin(const Args& a, int idx) { asm volatile("" : "+s"(idx)); return a.in[idx]; }
__device__ __forceinline__ float bf2f(bf16_t v) { return __uint_as_float(((unsigned)v) << 16); }
__device__ __forceinline__ bf16_t f2bf(float f) { unsigned u = __float_as_uint(f); u += 0x7FFFu + ((u >> 16) & 1u); return (bf16_t)(u >> 16); }
__device__ __forceinline__ unsigned pk2(float lo, float hi) { return (unsigned)f2bf(lo) | ((unsigned)f2bf(hi) << 16); }
__device__ __forceinline__ float wsum(float v) { for (int o = 32; o > 0; o >>= 1) v += __shfl_xor(v, o); return v; }
__device__ __forceinline__ float wmax(float v) { for (int o = 32; o > 0; o >>= 1) v = fmaxf(v, __shfl_xor(v, o)); return v; }
__device__ __forceinline__ float silu_f(float x) { return x / (1.0f + __expf(-x)); }
__device__ __forceinline__ float sigmoid_f(float x) { return 1.0f / (1.0f + __expf(-x)); }
__device__ __forceinline__ float softplus_f(float x) { return fmaxf(x, 0.f) + log1pf(__expf(-fabsf(x))); }
__device__ __forceinline__ int rel_bucket(int dist) {
    dist = dist < 0 ? 0 : dist;
    if (dist < 16) return dist;
    const float ratio = (float)dist / 16.0f;
    int large = 16 + (int)(logf(ratio) / 2.0794415416798357f * 16.0f);
    return large < 31 ? large : 31;
}
__device__ __forceinline__ float dot2(const bf16_t* kp, int lane, float q0, float q1) {
    const unsigned w = *(const unsigned*)(kp + 2 * lane);
    return wsum(q0 * __uint_as_float(w << 16) + q1 * __uint_as_float(w & 0xffff0000u));
}
struct OAcc { float m, l, o0, o1; };
__device__ __forceinline__ void oacc_add(OAcc& a, float s, const bf16_t* vp, int lane) {
    const unsigned w = *(const unsigned*)(vp + 2 * lane);
    const float mn = fmaxf(a.m, s), al = __expf(a.m - mn), p = __expf(s - mn);
    a.l = a.l * al + p; a.o0 = a.o0 * al + p * __uint_as_float(w << 16); a.o1 = a.o1 * al + p * __uint_as_float(w & 0xffff0000u); a.m = mn;
}

struct CvtJob { const float* src; int ld, col0; bf16_t* dst; int nrows, K; };
constexpr int NJOBS = 16;
__device__ __forceinline__ CvtJob get_job(const Args& a, int j) {
    unsigned char* ws = a.ws;
    bf16_t* wtin[4] = {(bf16_t*)(ws + WS_WTIN0), (bf16_t*)(ws + WS_WTIN1), (bf16_t*)(ws + WS_WTIN2), (bf16_t*)(ws + WS_WTIN3)};
    bf16_t* wtout = (bf16_t*)(ws + WS_WTOUT); bf16_t* wtsk = (bf16_t*)(ws + WS_WTSK);
    switch (j) {
    case 0:  return CvtJob{gin(a, I_WINA), 7216, 0,    wtin[0], 5120, 2048};
    case 1:  return CvtJob{gin(a, I_WINA), 7216, 5168, wtin[0] + (size_t)5120 * 2048, 2048, 2048};
    case 2:  return CvtJob{gin(a, I_WINA), 7216, 5120, wtsk, 48, 2048};
    case 3:  return CvtJob{gin(a, I_WOUTA), 2048, 0,   wtout, 2048, 2048};
    case 4:  return CvtJob{gin(a, I_WINB), 5120, 0,    wtin[1], 5120, 2048};
    case 5:  return CvtJob{gin(a, I_WOUTB), 2048, 0,   wtout + (size_t)1 * 2048 * 2048, 2048, 2048};
    case 6:  return CvtJob{gin(a, I_WINC), 8192, 0,    wtin[2], 8192, 2048};
    case 7:  return CvtJob{gin(a, I_WOUTC), 2048, 0,   wtout + (size_t)2 * 2048 * 2048, 2048, 2048};
    case 8:  return CvtJob{gin(a, I_WIND), 8208, 0,    wtin[3], 6144, 2048};
    case 9:  return CvtJob{gin(a, I_WIND), 8208, 6160, wtin[3] + (size_t)6144 * 2048, 2048, 2048};
    case 10: return CvtJob{gin(a, I_WIND), 8208, 6144, wtsk + (size_t)48 * 2048, 16, 2048};
    case 11: return CvtJob{gin(a, I_WOUTD), 2048, 0,   wtout + (size_t)3 * 2048 * 2048, 2048, 2048};
    case 12: return CvtJob{gin(a, I_W1K), 128, 0, (bf16_t*)(ws + WS_W1T), 128, 4096};
    case 13: return CvtJob{gin(a, I_W1V), 128, 0, (bf16_t*)(ws + WS_W1T) + (size_t)128 * 4096, 128, 4096};
    case 14: return CvtJob{gin(a, I_W2K), 128, 0, (bf16_t*)(ws + WS_W2T), 128, 128};
    default: return CvtJob{gin(a, I_W2V), 128, 0, (bf16_t*)(ws + WS_W2T) + (size_t)128 * 128, 128, 128};
    }
}
__device__ __forceinline__ int job_tiles(const CvtJob& jb) { return (jb.K / 64) * ((jb.nrows + 63) / 64); }

__device__ void phase_convert(const Args& a, unsigned char* lds) {
    int tid = threadIdx.x; asm volatile("" : "+v"(tid));
    float* tl = (float*)lds;
    int total = 0;
    for (int j = 0; j < NJOBS; ++j) total += job_tiles(get_job(a, j));
    for (int t = blockIdx.x; t < total; t += gridDim.x) {
        int j = 0, base = 0; CvtJob jb = get_job(a, 0);
        for (;;) { const int nt = job_tiles(jb); if (t < base + nt) break; base += nt; ++j; jb = get_job(a, j); }
        const int lt = t - base, nkt = jb.K / 64, tk = lt % nkt, tn = lt / nkt, k0 = tk * 64, n0 = tn * 64;
        { const int r = tid >> 4, c4 = (tid & 15) * 4;
#pragma unroll
          for (int ps = 0; ps < 2; ++ps) { const int k = r + 32 * ps;
              f32x4 v = {0.f, 0.f, 0.f, 0.f};
              if (n0 + c4 < jb.nrows) v = *(const f32x4*)(jb.src + (size_t)(k0 + k) * jb.ld + jb.col0 + n0 + c4);
              tl[k * 65 + c4 + 0] = v[0]; tl[k * 65 + c4 + 1] = v[1]; tl[k * 65 + c4 + 2] = v[2]; tl[k * 65 + c4 + 3] = v[3]; } }
        __syncthreads();
        { const int n = tid >> 3, k8 = (tid & 7) * 8;
          if (n0 + n < jb.nrows) { u32x4 w;
              w.x = pk2(tl[(k8 + 0) * 65 + n], tl[(k8 + 1) * 65 + n]); w.y = pk2(tl[(k8 + 2) * 65 + n], tl[(k8 + 3) * 65 + n]);
              w.z = pk2(tl[(k8 + 4) * 65 + n], tl[(k8 + 5) * 65 + n]); w.w = pk2(tl[(k8 + 6) * 65 + n], tl[(k8 + 7) * 65 + n]);
              *(u32x4*)(jb.dst + (size_t)(n0 + n) * jb.K + k0 + k8) = w; } }
        __syncthreads();
    }
    { const float* x = gin(a, I_X); bf16_t* xb = (bf16_t*)(a.ws + WS_XB);
      for (size_t i = (size_t)blockIdx.x * 512 + tid; i < (size_t)M * DM / 8; i += (size_t)gridDim.x * 512) {
          const f32x4 v0 = *(const f32x4*)(x + i * 8), v1 = *(const f32x4*)(x + i * 8 + 4);
          u32x4 w; w.x = pk2(v0[0], v0[1]); w.y = pk2(v0[2], v0[3]); w.z = pk2(v1[0], v1[1]); w.w = pk2(v1[2], v1[3]);
          *(u32x4*)(xb + i * 8) = w; } }
    if (blockIdx.x < 2) {
        const float* pe = gin(a, blockIdx.x == 0 ? I_PEK : I_PEV); const float* w1 = gin(a, blockIdx.x == 0 ? I_W1K : I_W1V);
        float* c1 = (float*)(a.ws + WS_C1) + blockIdx.x * 128;
        const int e = tid & 127, part = tid >> 7; float s = 0.f;
        for (int i = part * 1024; i < part * 1024 + 1024; ++i) s += pe[i] * w1[(size_t)i * 128 + e];
        tl[part * 128 + e] = s; __syncthreads();
        if (tid < 128) c1[tid] = tl[tid] + tl[128 + tid] + tl[256 + tid] + tl[384 + tid];
        __syncthreads();
    }
}

template <int NC>
__device__ void skinny_gemm(const bf16_t* xb, const bf16_t* wsk, float* out) {
    int tid = threadIdx.x; asm volatile("" : "+v"(tid)); const int wid = tid >> 6, lane = tid & 63, r16 = lane & 15, kq = lane >> 4;
    for (int t = blockIdx.x * 8 + wid; t < M / 16; t += gridDim.x * 8) {
        f32x4 acc[NC];
#pragma unroll
        for (int c = 0; c < NC; ++c) acc[c] = (f32x4){0.f, 0.f, 0.f, 0.f};
        const bf16_t* ap = xb + (size_t)(t * 16 + r16) * DM + 8 * kq;
        const bf16_t* bp = wsk + (size_t)r16 * DM + 8 * kq;
        for (int k0 = 0; k0 < DM; k0 += 32) {
            const bf16x8 av = *(const bf16x8*)(ap + k0);
#pragma unroll
            for (int c = 0; c < NC; ++c) { const bf16x8 bv = *(const bf16x8*)(bp + (size_t)c * 16 * DM + k0);
                acc[c] = __builtin_amdgcn_mfma_f32_16x16x32_bf16(av, bv, acc[c], 0, 0, 0); }
        }
#pragma unroll
        for (int c = 0; c < NC; ++c)
#pragma unroll
            for (int j = 0; j < 4; ++j) out[(size_t)(t * 16 + kq * 4 + j) * (16 * NC) + c * 16 + r16] = acc[c][j];
    }
}

__device__ void phase_ln(float* X, const float* g, const float* b, bf16_t* xb) {
    int tid = threadIdx.x; asm volatile("" : "+v"(tid)); const int wid = tid >> 6, lane = tid & 63;
    for (int row = blockIdx.x * 8 + wid; row < M; row += gridDim.x * 8) {
        f32x4* xr = (f32x4*)(X + (size_t)row * DM);
        f32x4 v[8]; float s = 0.f;
#pragma unroll
        for (int i = 0; i < 8; ++i) { v[i] = xr[lane + 64 * i]; s += (v[i][0] + v[i][1]) + (v[i][2] + v[i][3]); }
        const float mean = wsum(s) * (1.0f / DM);
        float q = 0.f;
#pragma unroll
        for (int i = 0; i < 8; ++i) { const f32x4 d = v[i] - mean; q += (d[0] * d[0] + d[1] * d[1]) + (d[2] * d[2] + d[3] * d[3]); }
        const float rstd = 1.0f / sqrtf(wsum(q) * (1.0f / DM) + LN_EPS);
#pragma unroll
        for (int i = 0; i < 8; ++i) { const int c = (lane + 64 * i);
            const f32x4 gg = ((const f32x4*)g)[c], bb = ((const f32x4*)b)[c];
            const f32x4 y = (v[i] - mean) * rstd * gg + bb;
            xr[c] = y;
            if (xb) { u32x2 w; w.x = pk2(y[0], y[1]); w.y = pk2(y[2], y[3]); *(u32x2*)(xb + (size_t)row * DM + c * 4) = w; } }
    }
}
__device__ void naive_compress(const Args& a, unsigned char* lds) {
    int tid = threadIdx.x; asm volatile("" : "+v"(tid));
    float* blk = (float*)lds;
    float* red = blk + 4096;
    float* hid = red + 512;
    const bf16_t* H = (const bf16_t*)(a.ws + WS_H);
    for (int t = blockIdx.x; t < 2 * Bz * 128 * 4; t += gridDim.x) {
        const int kv = t & 1, g = (t >> 1) & 3, n = (t >> 3) & 127, b = t >> 10;
        bf16_t* out = (bf16_t*)(a.ws + (kv ? WS_VCMP : WS_KCMP)) + ((size_t)((b * 4 + g) * 128 + n)) * 128;
        if (n == 127) { if (tid < 128) out[tid] = 0; continue; }
        const float* pe = gin(a, kv ? I_PEV : I_PEK); const float* w1 = gin(a, kv ? I_W1V : I_W1K); const float* w2 = gin(a, kv ? I_W2V : I_W2K);
        const int col0 = (kv ? 2560 : 2048) + g * 128;
        for (int i = tid; i < 4096; i += 512) { const int l = i >> 7, d = i & 127;
            blk[i] = bf2f(H[(size_t)(b * S + 16 * n + l) * 7168 + col0 + d]) + pe[i]; }
        __syncthreads();
        { const int e = tid & 127, part = tid >> 7; float s = 0.f;
          for (int i = part * 1024; i < part * 1024 + 1024; ++i) s += blk[i] * w1[(size_t)i * 128 + e];
          red[part * 128 + e] = s; }
        __syncthreads();
        if (tid < 128) hid[tid] = silu_f(red[tid] + red[128 + tid] + red[256 + tid] + red[384 + tid]);
        __syncthreads();
        if (tid < 128) { float s = 0.f; for (int e = 0; e < 128; ++e) s += hid[e] * w2[e * 128 + tid]; out[tid] = f2bf(s); }
        __syncthreads();
    }
}

__device__ void naive_nsa(const Args& a, unsigned char* lds) {
    int tid = threadIdx.x; asm volatile("" : "+v"(tid)); const int wid = tid >> 6, lane = tid & 63;
    float* ps = (float*)(lds + LDS_MAIN) + wid * 128;
    const bf16_t* H = (const bf16_t*)(a.ws + WS_H); const float* relb = gin(a, I_RELB);
    const bf16_t* KC = (const bf16_t*)(a.ws + WS_KCMP); const bf16_t* VC = (const bf16_t*)(a.ws + WS_VCMP);
    const float* GL = (const float*)(a.ws + WS_GL); bf16_t* U = (bf16_t*)(a.ws + WS_U);
    unsigned* SELM = (unsigned*)(a.ws + WS_SELM);
    constexpr int LD = 7168;
    for (int t = blockIdx.x * 8 + wid; t < M * 4; t += gridDim.x * 8) {
        const int row = t >> 2, g = t & 3, b = row / S, s = row % S;
        const bf16_t* hrow = H + (size_t)row * LD;
        int nv = s >= 31 ? (s - 31) / 16 + 1 : 0; if (nv > NCMP) nv = NCMP;
        const bf16_t* kc = KC + (size_t)(b * 4 + g) * 128 * 128; const bf16_t* vc = VC + (size_t)(b * 4 + g) * 128 * 128;
        float psum0 = 0.f, psum1 = 0.f; float oc[4][2];
#pragma unroll
        for (int hh = 0; hh < 4; ++hh) {
            const int head = g * 4 + hh;
            const unsigned qw = *(const unsigned*)(hrow + head * 128 + 2 * lane);
            const float q0 = __uint_as_float(qw << 16), q1 = __uint_as_float(qw & 0xffff0000u);
            float sc0 = NEG_INF, sc1 = NEG_INF;
            for (int n = 0; n < nv; ++n) {
                const float d = dot2(kc + n * 128, lane, q0, q1) * SCALE + relb[rel_bucket(s - (16 * n + 31)) * 16 + head];
                if (lane == (n & 63)) { if (n < 64) sc0 = d; else sc1 = d; }
            }
            const float mx = wmax(fmaxf(sc0, sc1));
            float p0 = (lane < nv) ? __expf(sc0 - mx) : 0.f, p1 = (lane + 64 < nv) ? __expf(sc1 - mx) : 0.f;
            const float den = wsum(p0 + p1), inv = 1.0f / fmaxf(den, 1e-30f);
            p0 *= inv; p1 *= inv; psum0 += p0; psum1 += p1;
            float o0 = 0.f, o1 = 0.f;
            for (int n = 0; n < nv; ++n) { const float pn = __shfl(n < 64 ? p0 : p1, n & 63);
                const unsigned w = *(const unsigned*)(vc + n * 128 + 2 * lane);
                o0 += pn * __uint_as_float(w << 16); o1 += pn * __uint_as_float(w & 0xffff0000u); }
            oc[hh][0] = o0; oc[hh][1] = o1;
        }
        ps[lane] = psum0; ps[64 + lane] = psum1;
        asm volatile("s_waitcnt lgkmcnt(0)" ::: "memory"); __builtin_amdgcn_wave_barrier();
        float val = -3e38f;
        if (lane < 32) { const int j = lane;
            const float imp = ps[4 * j] + ps[4 * j + 1] + ps[4 * j + 2] + 0.5f * ps[4 * j + 3] + (j > 0 ? 0.5f * ps[4 * j - 1] : 0.f);
            const int cur = s >> 6; const bool allowed = j <= cur, forced = allowed && (j == 0 || j == cur || j == cur - 1);
            val = forced ? 1e4f : (allowed ? imp : NEG_INF); }
        __builtin_amdgcn_wave_barrier();
        unsigned sel = 0;
        for (int r = 0; r < 8; ++r) { const float mx = wmax(val); const unsigned long long bal = __ballot(val == mx); const int j = __ffsll((long long)bal) - 1;
            if (mx > -5e29f) sel |= 1u << j; if (lane == j) val = -3e38f; }
        if (lane == 0) SELM[row * 4 + g] = sel;
#pragma unroll
        for (int hh = 0; hh < 4; ++hh) {
            const int head = g * 4 + hh;
            const unsigned qw = *(const unsigned*)(hrow + head * 128 + 2 * lane);
            const float q0 = __uint_as_float(qw << 16), q1 = __uint_as_float(qw & 0xffff0000u);
            OAcc as{NEG_INF, 0.f, 0.f, 0.f};
            for (int j = 0; j < 32; ++j) if ((sel >> j) & 1u) {
                const int kend = (64 * j + 63 < s) ? 64 * j + 63 : s;
                for (int key = 64 * j; key <= kend; ++key) { const bf16_t* kr = H + (size_t)(b * S + key) * LD;
                    const float sc = dot2(kr + 3072 + g * 128, lane, q0, q1) * SCALE + relb[rel_bucket(s - key) * 16 + head];
                    oacc_add(as, sc, kr + 3584 + g * 128, lane); } }
            OAcc aw{NEG_INF, 0.f, 0.f, 0.f};
            for (int key = (s - 511 > 0 ? s - 511 : 0); key <= s; ++key) { const bf16_t* kr = H + (size_t)(b * S + key) * LD;
                const float sc = dot2(kr + 4096 + g * 128, lane, q0, q1) * SCALE + relb[rel_bucket(s - key) * 16 + head];
                oacc_add(aw, sc, kr + 4608 + g * 128, lane); }
            const float is = 1.0f / fmaxf(as.l, 1e-30f), iw = 1.0f / fmaxf(aw.l, 1e-30f);
            const float g0 = sigmoid_f(GL[(size_t)row * 48 + head * 3 + 0]), g1 = sigmoid_f(GL[(size_t)row * 48 + head * 3 + 1]), g2 = sigmoid_f(GL[(size_t)row * 48 + head * 3 + 2]);
            const float o0 = g0 * oc[hh][0] + g1 * as.o0 * is + g2 * aw.o0 * iw, o1 = g0 * oc[hh][1] + g1 * as.o1 * is + g2 * aw.o1 * iw;
            const unsigned zw = *(const unsigned*)(hrow + 5120 + head * 128 + 2 * lane);
            *(unsigned*)(U + (size_t)row * WIDTH + head * 128 + 2 * lane) = pk2(o0 * silu_f(__uint_as_float(zw << 16)), o1 * silu_f(__uint_as_float(zw & 0xffff0000u)));
        }
    }
}

__device__ void naive_swa(const Args& a) {
    int tid = threadIdx.x; asm volatile("" : "+v"(tid)); const int wid = tid >> 6, lane = tid & 63;
    const bf16_t* H = (const bf16_t*)(a.ws + WS_H); const float* relb = gin(a, I_RELB); const float* sinks = gin(a, I_SINKS); bf16_t* U = (bf16_t*)(a.ws + WS_U);
    constexpr int LD = 5120;
    for (int t = blockIdx.x * 8 + wid; t < M * NH; t += gridDim.x * 8) {
        const int row = t >> 4, head = t & 15, g = head >> 2, b = row / S, s = row % S;
        const bf16_t* hrow = H + (size_t)row * LD;
        const unsigned qw = *(const unsigned*)(hrow + head * 128 + 2 * lane);
        const float q0 = __uint_as_float(qw << 16), q1 = __uint_as_float(qw & 0xffff0000u);
        OAcc ac{sinks[head], 1.f, 0.f, 0.f};
        for (int key = (s - 127 > 0 ? s - 127 : 0); key <= s; ++key) { const bf16_t* kr = H + (size_t)(b * S + key) * LD;
            const float sc = dot2(kr + 2048 + g * 128, lane, q0, q1) * SCALE + relb[rel_bucket(s - key) * 16 + head];
            oacc_add(ac, sc, kr + 2560 + g * 128, lane); }
        const float il = 1.0f / fmaxf(ac.l, 1e-30f);
        const unsigned zw = *(const unsigned*)(hrow + 3072 + head * 128 + 2 * lane);
        *(unsigned*)(U + (size_t)row * WIDTH + head * 128 + 2 * lane) = pk2(ac.o0 * il * silu_f(__uint_as_float(zw << 16)), ac.o1 * il * silu_f(__uint_as_float(zw & 0xffff0000u)));
    }
}

__device__ void naive_sb(const Args& a) {
    int tid = threadIdx.x; asm volatile("" : "+v"(tid)); const int wid = tid >> 6, lane = tid & 63;
    const bf16_t* H = (const bf16_t*)(a.ws + WS_H); bf16_t* U = (bf16_t*)(a.ws + WS_U);
    constexpr int LD = 8192;
    for (int t = blockIdx.x * 8 + wid; t < M * NH; t += gridDim.x * 8) {
        const int row = t >> 4, head = t & 15, b = row / S, s = row % S;
        const bf16_t* hrow = H + (size_t)row * LD;
        const unsigned qw = *(const unsigned*)(hrow + head * 128 + 2 * lane);
        const float q0 = __uint_as_float(qw << 16), q1 = __uint_as_float(qw & 0xffff0000u);
        float R = 0.f, o0 = 0.f, o1 = 0.f;
        for (int key = s - 1; key >= 0; --key) { const bf16_t* kr = H + (size_t)(b * S + key) * LD;
            const float z = dot2(kr + 2048 + head * 128, lane, q0, q1) * SCALE;
            const float L = -softplus_f(z);
            const float av = __expf(z + L + R);
            const unsigned w = *(const unsigned*)(kr + 4096 + head * 128 + 2 * lane);
            o0 += av * __uint_as_float(w << 16); o1 += av * __uint_as_float(w & 0xffff0000u);
            R += L; }
        const unsigned zw = *(const unsigned*)(hrow + 6144 + head * 128 + 2 * lane);
        *(unsigned*)(U + (size_t)row * WIDTH + head * 128 + 2 * lane) = pk2(o0 * silu_f(__uint_as_float(zw << 16)), o1 * silu_f(__uint_as_float(zw & 0xffff0000u)));
    }
}

__device__ void fox_scan(const Args& a) {
    int tid = threadIdx.x; asm volatile("" : "+v"(tid)); const int wid = tid >> 6, lane = tid & 63;
    const float* FL = (const float*)(a.ws + WS_FL); float* CF = (float*)(a.ws + WS_CF); const float* fb = gin(a, I_FGB);
    for (int t = blockIdx.x * 8 + wid; t < Bz * NH; t += gridDim.x * 8) {
        const int b = t >> 4, h = t & 15; float carry = 0.f;
        for (int c = 0; c < S / 64; ++c) { const int s = c * 64 + lane;
            const float x = FL[(size_t)(b * S + s) * 16 + h] + fb[h];
            float v = -softplus_f(-x);
            for (int o = 1; o < 64; o <<= 1) { const float u = __shfl_up(v, o); if (lane >= o) v += u; }
            v += carry; CF[(size_t)(b * 16 + h) * S + s] = v; carry = __shfl(v, 63); }
    }
}
__device__ void naive_fox(const Args& a) {
    int tid = threadIdx.x; asm volatile("" : "+v"(tid)); const int wid = tid >> 6, lane = tid & 63;
    const bf16_t* H = (const bf16_t*)(a.ws + WS_H); bf16_t* U = (bf16_t*)(a.ws + WS_U); const float* CF = (const float*)(a.ws + WS_CF);
    constexpr int LD = 8192;
    for (int t = blockIdx.x * 8 + wid; t < M * NH; t += gridDim.x * 8) {
        const int row = t >> 4, head = t & 15, b = row / S, s = row % S;
        const bf16_t* hrow = H + (size_t)row * LD; const float* cf = CF + (size_t)(b * 16 + head) * S;
        const unsigned qw = *(const unsigned*)(hrow + head * 128 + 2 * lane);
        const float q0 = __uint_as_float(qw << 16), q1 = __uint_as_float(qw & 0xffff0000u);
        const float ct = cf[s];
        OAcc ac{NEG_INF, 0.f, 0.f, 0.f};
        for (int key = 0; key <= s; ++key) { const bf16_t* kr = H + (size_t)(b * S + key) * LD;
            const float sc = dot2(kr + 2048 + head * 128, lane, q0, q1) * SCALE + (ct - cf[key]);
            oacc_add(ac, sc, kr + 4096 + head * 128, lane); }
        const float il = 1.0f / fmaxf(ac.l, 1e-30f);
        const unsigned zw = *(const unsigned*)(hrow + 6144 + head * 128 + 2 * lane);
        *(unsigned*)(U + (size_t)row * WIDTH + head * 128 + 2 * lane) = pk2(ac.o0 * il * silu_f(__uint_as_float(zw << 16)), ac.o1 * il * silu_f(__uint_as_float(zw & 0xffff0000u)));
    }
}
constexpr int NPH = 21;
__host__ __device__ inline bool phase_empty(int ph) { return ph == 7 || ph == 12; }
__device__ __forceinline__ int ldh_of(int layer) { return layer == 0 ? 7168 : (layer == 1 ? 5120 : 8192); }

__global__ void __launch_bounds__(512, 2) mega(Args a) {
    extern __shared__ __attribute__((aligned(16))) unsigned char lds[];
    cg::grid_group grid = cg::this_grid();
    unsigned char* ws = a.ws;
    bf16_t* H = (bf16_t*)(ws + WS_H); bf16_t* XB = (bf16_t*)(ws + WS_XB); bf16_t* U = (bf16_t*)(ws + WS_U);
    for (int ph = a.ph_lo; ph < a.ph_hi; ++ph) {
        if (phase_empty(ph)) continue;
        if (ph == 0) { phase_convert(a, lds); }
        else {
            const int layer = (ph - 1) / 5, k = (ph - 1) % 5;
            if (k == 0) {
                const size_t wo = layer == 0 ? WS_WTIN0 : (layer == 1 ? WS_WTIN1 : (layer == 2 ? WS_WTIN2 : WS_WTIN3));
                const int N = ldh_of(layer);
                pg8::Gemm g{XB, (const bf16_t*)(ws + wo), M, N, DM}; pg8::StaticOrder So; So.init(M, N, (int)gridDim.x, (int)blockIdx.x);
                pg8::EpiH E{H, N};
                pg8::gemm_phase<pg8::EpiH, pg8::StaticOrder, false>((PG8_LAS unsigned char*)lds, g, So, E, nullptr);
                if (layer == 0) skinny_gemm<3>(XB, (const bf16_t*)(ws + WS_WTSK), (float*)(ws + WS_GL));
                if (layer == 3) skinny_gemm<1>(XB, (const bf16_t*)(ws + WS_WTSK) + (size_t)48 * 2048, (float*)(ws + WS_FL));
            } else if (k == 1) {
                if (layer == 0) naive_compress(a, lds);
                if (layer == 3) fox_scan(a);
            } else if (k == 2) {
                if (layer == 0) naive_nsa(a, lds);
                else if (layer == 1) naive_swa(a);
                else if (layer == 2) naive_sb(a);
                else naive_fox(a);
            } else if (k == 3) {
                pg8::Gemm g{U, (const bf16_t*)(ws + WS_WTOUT) + (size_t)layer * 2048 * 2048, M, DM, WIDTH}; pg8::StaticOrder So; So.init(M, DM, (int)gridDim.x, (int)blockIdx.x);
                pg8::EpiRes E{a.out, layer == 0 ? gin(a, I_X) : a.out, DM, DN_ALPHA};
                pg8::gemm_phase<pg8::EpiRes, pg8::StaticOrder, false>((PG8_LAS unsigned char*)lds, g, So, E, nullptr);
            } else {
                const int ig = layer == 0 ? I_LNGA : (layer == 1 ? I_LNGB : (layer == 2 ? I_LNGC : I_LNGD));
                phase_ln(a.out, gin(a, ig), gin(a, ig + 1), layer < 3 ? XB : nullptr);
            }
        }
        bool more = false; for (int q = ph + 1; q < a.ph_hi; ++q) if (!phase_empty(q)) more = true;
        if (more) grid.sync();
    }
}

#ifndef MK_MULTI
#define MK_MULTI 0
#endif
extern "C" void kernel_launch(void* const* d_in, const int* in_sizes, int n_in, void* d_out, int out_size, void* d_ws, size_t ws_size, hipStream_t stream) {
    static int grid = 0;
    if (grid == 0) {
        if (n_in != 26 || out_size != M * DM || ws_size < WS_END) { fprintf(stderr, "kernel_launch: unexpected shapes: n_in %d out %d ws %zu (need %zu)\n", n_in, out_size, ws_size, (size_t)WS_END); grid = -1; return; }
        int dev = 0, cus = 0, per_cu = 0;
        hipGetDevice(&dev); hipDeviceGetAttribute(&cus, hipDeviceAttributeMultiprocessorCount, dev);
        if (hipFuncSetAttribute((const void*)mega, hipFuncAttributeMaxDynamicSharedMemorySize, LDS_BYTES) != hipSuccess) { fprintf(stderr, "kernel_launch: hipFuncSetAttribute failed\n"); grid = -1; return; }
        if (hipOccupancyMaxActiveBlocksPerMultiprocessor(&per_cu, (const void*)mega, 512, LDS_BYTES) != hipSuccess || per_cu < 1) { fprintf(stderr, "kernel_launch: occupancy query failed (%d)\n", per_cu); grid = -1; return; }
        grid = cus * 1;
        fprintf(stderr, "kernel_launch: cus %d per_cu %d grid %d ws %zu need %zu\n", cus, per_cu, grid, ws_size, (size_t)WS_END);
    }
    if (grid < 0) return;
    Args a{};
    for (int i = 0; i < 26; ++i) a.in[i] = (const float*)d_in[i];
    a.out = (float*)d_out; a.ws = (unsigned char*)d_ws;
#if MK_MULTI
    for (int ph = 0; ph < NPH; ++ph) {
        if (phase_empty(ph)) continue;
        a.ph_lo = ph; a.ph_hi = ph + 1;
        void* args[] = {&a};
        hipError_t e = hipLaunchCooperativeKernel((const void*)mega, dim3(grid), dim3(512), args, LDS_BYTES, stream);
        if (e != hipSuccess) { fprintf(stderr, "kernel_launch: launch of phase %d failed: %s\n", ph, hipGetErrorString(e)); break; }
    }
#else
    a.ph_lo = 0; a.ph_hi = NPH;
    void* args[] = {&a};
    hipError_t e = hipLaunchCooperativeKernel((const void*)mega, dim3(grid), dim3(512), args, LDS_BYTES, stream);
    if (e != hipSuccess) fprintf(stderr, "kernel_launch: cooperative launch failed: %s (grid %d)\n", hipGetErrorString(e), grid);
#endif
}
```

```cpp
#include <hip/hip_runtime.h>
#include <hip/hip_cooperative_groups.h>
#include <cstdio>
#include <cstdint>
namespace cg = cooperative_groups;
namespace pg8 {
#define PG8_LAS __attribute__((address_space(3)))
typedef unsigned short bf16_t;
typedef short bf16x8 __attribute__((ext_vector_type(8)));
typedef float f32x4 __attribute__((ext_vector_type(4)));
typedef unsigned u32x4 __attribute__((ext_vector_type(4)));
constexpr int BM = 256, BK = 64, HALF = 128, HTB = HALF * BK * 2  , STAGE_BYTES = 8 * HTB, NXCD = 8, WGM = 8;

__host__ __device__ __forceinline__ int lds_byte(int r, int c) { const int st = (r >> 4) * 2 + (c >> 5), rr = r & 15, cc = c & 31, ob = rr * 64 + cc * 2; return st * 1024 + (ob ^ (((ob >> 9) & 1) << 5)); }
__host__ __device__ __forceinline__ void stage_rc(int b, int& R, int& C) { const int st = b / 1024, sb = b % 1024, swz = sb ^ (((sb >> 9) & 1) << 5); R = (st >> 1) * 16 + swz / 64; C = (st & 1) * 32 + (swz % 64) / 2; }
__host__ __device__ __forceinline__ int perm32(int rho) { const int n = rho >> 4, i = rho & 15; return 8 * (i >> 2) + 4 * n + (i & 3); }

struct Unit { int pm, pn; };
struct Gemm { const bf16_t* A; const bf16_t* Bt; int M, N, K; };

struct StaticOrder {
    int nM, nN, nwg, G, c;
    __host__ __device__ void init(int M, int N, int G_, int c_) { nM = M / BM; nN = N / BM; nwg = nM * nN; G = G_; c = c_; }
    __host__ __device__ bool next(int i, Unit& u) const {
        const long L = (long)i * G + c; if (L >= nwg) return false;
        int wgid = (int)L; { const int q = nwg / NXCD, r = nwg % NXCD, xcd = wgid % NXCD, off = wgid / NXCD; wgid = (xcd < r ? xcd * (q + 1) : r * (q + 1) + (xcd - r) * q) + off; }
        const int nig = WGM * nN, gid = wgid / nig, fm = gid * WGM, gsz = (nM - fm) < WGM ? (nM - fm) : WGM;
        u.pm = fm + ((wgid % nig) % gsz); u.pn = (wgid % nig) / gsz; return true;
    }
    __device__ __forceinline__ void a_ready(const Unit&) const {}
    __device__ __forceinline__ void done(const Unit&) const {}
};
__device__ __forceinline__ unsigned cvt_pk_bf16(float lo, float hi) { unsigned r; asm volatile("v_cvt_pk_bf16_f32 %0, %1, %2" : "=v"(r) : "v"(lo), "v"(hi)); return r; }
typedef float f32x2 __attribute__((ext_vector_type(2)));
typedef float f32x2 __attribute__((ext_vector_type(2)));
struct EpiH {
    static constexpr bool PERM = true, AFTER_DRAIN = false;
    bf16_t* O; int ldc;
    __device__ __forceinline__ void operator()(const f32x4 (&acc)[2][2][4][2], const Unit& u, int wr, int wc, int fr, int fq) const {
        const int row0 = u.pm * BM + wr * 64 + fr, col0 = u.pn * BM + wc * 32 + 8 * fq;
#pragma unroll
        for (int ai = 0; ai < 2; ++ai)
#pragma unroll
            for (int m = 0; m < 4; ++m) { bf16_t* rowp = O + (size_t)(row0 + ai * HALF + m * 16) * ldc + col0;
#pragma unroll
                for (int bj = 0; bj < 2; ++bj) { const f32x4 v0 = acc[ai][bj][m][0], v1 = acc[ai][bj][m][1];
                    u32x4 w; w.x = cvt_pk_bf16(v0[0], v0[1]); w.y = cvt_pk_bf16(v0[2], v0[3]); w.z = cvt_pk_bf16(v1[0], v1[1]); w.w = cvt_pk_bf16(v1[2], v1[3]);
                    *(u32x4*)(rowp + bj * HALF) = w; } }
    }
};
struct EpiRes {
    static constexpr bool PERM = false, AFTER_DRAIN = false;
    float* C; const float* R; int ldc; float alpha;
    __device__ __forceinline__ void operator()(const f32x4 (&acc)[2][2][4][2], const Unit& u, int wr, int wc, int fr, int fq) const {
        const int row0 = u.pm * BM + wr * 64 + fr, col0 = u.pn * BM + wc * 32 + 4 * fq;
#pragma unroll
        for (int ai = 0; ai < 2; ++ai)
#pragma unroll
            for (int m = 0; m < 4; ++m) { const size_t off = (size_t)(row0 + ai * HALF + m * 16) * ldc + col0;
#pragma unroll
                for (int bj = 0; bj < 2; ++bj)
#pragma unroll
                    for (int n = 0; n < 2; ++n) { const f32x4 r = *(const f32x4*)(R + off + bj * HALF + n * 16); *(f32x4*)(C + off + bj * HALF + n * 16) = acc[ai][bj][m][n] + alpha * r; }
                asm volatile("" ::: "memory"); }
    }
};
template <class Epi, class Sched, bool STAMP = false>
__device__ __forceinline__ void gemm_phase(PG8_LAS unsigned char* lds, const Gemm g, const Sched& S, const Epi& E, unsigned long long* stamps) {
    int tid_ = threadIdx.x; asm volatile("" : "+v"(tid_)); const int tid = tid_, wid = __builtin_amdgcn_readfirstlane(tid >> 6), lane = tid & 63, wr = wid >> 2, wc = wid & 3, fr = lane & 15, fq = lane >> 4;
    const int K = g.K, nt = K / BK;
    int ts_lo = 0, ts_hi = 0, nts = 0; const unsigned long long rt_entry = STAMP ? (unsigned long long)wall_clock64() : 0ull;
#define PG8_STAMP() do { if (STAMP && wid == 0 && nts < 64) { const unsigned long long _c = (unsigned long long)clock64(); \
        ts_lo = (lane == nts) ? (int)(unsigned)_c : ts_lo; ts_hi = (lane == nts) ? (int)(unsigned)(_c >> 32) : ts_hi; ++nts; } } while (0)
    PG8_STAMP();
    unsigned voffA[2], voffB[2];
#pragma unroll
    for (int i = 0; i < 2; ++i) { int R, C; stage_rc(tid * 16 + i * 8192, R, C); const int Rb = Epi::PERM ? ((R & ~31) + perm32(R & 31)) : R;
        voffA[i] = (unsigned)(R * K + C) * 2u; voffB[i] = (unsigned)(Rb * K + C) * 2u; }
    const size_t kstep = (size_t)(BK * 2);
    const size_t hstep = (size_t)HALF * K * 2;
    const size_t tstep = 2 * hstep;
    const unsigned ldsw = (unsigned)wid * 1024u;
    const int aoff = lds_byte(wr * 64 + fr, fq * 8), boff = lds_byte(wc * 32 + fr, fq * 8);
#define PG8_SA(b, h) (((b) * 2 + (h)) * HTB)
#define PG8_SB(b, h) ((4 + (b) * 2 + (h)) * HTB)
#define PG8_STAGE(bufoff, gbase, voff) do { _Pragma("unroll") for (int _i = 0; _i < 2; ++_i) \
        __builtin_amdgcn_global_load_lds((const unsigned*)((const char*)(gbase) + (voff)[_i]), (PG8_LAS unsigned*)(lds + (bufoff) + ldsw + _i * 8192), 16, 0, 0); } while (0)
#define PG8_LDA(dst, b, h) do { _Pragma("unroll") for (int m = 0; m < 4; ++m) _Pragma("unroll") for (int k = 0; k < 2; ++k) dst[m][k] = *(const PG8_LAS bf16x8*)(lds + PG8_SA(b, h) + aoff + m * 2048 + k * 1024); } while (0)
#define PG8_LDB(dst, b, h) do { _Pragma("unroll") for (int n = 0; n < 2; ++n) _Pragma("unroll") for (int k = 0; k < 2; ++k) dst[n][k] = *(const PG8_LAS bf16x8*)(lds + PG8_SB(b, h) + boff + n * 2048 + k * 1024); } while (0)
#define PG8_MMA(ai, bj, At, Bt) do { __builtin_amdgcn_s_setprio(1); _Pragma("unroll") for (int m = 0; m < 4; ++m) _Pragma("unroll") for (int n = 0; n < 2; ++n) _Pragma("unroll") for (int k = 0; k < 2; ++k) \
        acc[ai][bj][m][n] = __builtin_amdgcn_mfma_f32_16x16x32_bf16(Bt[n][k], At[m][k], acc[ai][bj][m][n], 0, 0, 0); __builtin_amdgcn_s_setprio(0); } while (0)
#define PG8_WAIT_V(n) asm volatile("s_waitcnt vmcnt(" #n ")" ::: "memory")
#define PG8_WAIT_L(n) asm volatile("s_waitcnt lgkmcnt(" #n ")" ::: "memory")
#define PG8_BAR __builtin_amdgcn_s_barrier()
#define PG8_SCHED __builtin_amdgcn_sched_barrier(0)
    Unit cur, nxt; int ui = 0;
    if (!S.next(0, cur)) return;
    f32x4 acc[2][2][4][2];
#pragma unroll
    for (int a = 0; a < 2; ++a)
#pragma unroll
        for (int b = 0; b < 2; ++b)
#pragma unroll
            for (int m = 0; m < 4; ++m)
#pragma unroll
                for (int n = 0; n < 2; ++n) acc[a][b][m][n] = (f32x4){0.f, 0.f, 0.f, 0.f};
    bf16x8 At[4][2], B0[2][2], B1[2][2];
    const char* cA = (const char*)g.A + (size_t)cur.pm * tstep; const char* cB = (const char*)g.Bt + (size_t)cur.pn * tstep;
    S.a_ready(cur);
    PG8_STAGE(PG8_SB(0, 0), cB, voffB); PG8_STAGE(PG8_SA(0, 0), cA, voffA); PG8_STAGE(PG8_SB(0, 1), cB + hstep, voffB); PG8_STAGE(PG8_SA(0, 1), cA + hstep, voffA);
    if (wr == 1) PG8_BAR;
    PG8_WAIT_V(4); PG8_BAR;
    PG8_STAGE(PG8_SB(1, 0), cB + kstep, voffB); PG8_STAGE(PG8_SA(1, 0), cA + kstep, voffA); PG8_STAGE(PG8_SB(1, 1), cB + hstep + kstep, voffB);
    PG8_WAIT_V(6); PG8_BAR;
    PG8_STAMP();
    for (;;) {
        const bool has_next = S.next(ui + 1, nxt);
        const char* nA = has_next ? (const char*)g.A + (size_t)nxt.pm * tstep : cA; const char* nB = has_next ? (const char*)g.Bt + (size_t)nxt.pn * tstep : cB;
        for (int t = 0; t < nt; t += 2) {
            const bool last = (t == nt - 2);
            const char* a1 = cA + (size_t)(t + 1) * kstep;
            const char* a2 = last ? nA : cA + (size_t)(t + 2) * kstep; const char* b2 = last ? nB : cB + (size_t)(t + 2) * kstep;
            const char* a3 = a2 + kstep; const char* b3 = b2 + kstep;
            if (last && has_next) S.a_ready(nxt);
            PG8_LDB(B0, 0, 0); PG8_SCHED; PG8_LDA(At, 0, 0); PG8_STAGE(PG8_SA(1, 1), a1 + hstep, voffA);
            PG8_WAIT_L(8); PG8_BAR; PG8_WAIT_L(0); PG8_MMA(0, 0, At, B0); PG8_BAR; PG8_SCHED;
            PG8_LDB(B1, 0, 1); PG8_STAGE(PG8_SB(0, 0), b2, voffB);
            PG8_BAR; PG8_WAIT_L(0); PG8_MMA(0, 1, At, B1); PG8_BAR;
            PG8_LDA(At, 0, 1); PG8_STAGE(PG8_SA(0, 0), a2, voffA);
            PG8_BAR; PG8_WAIT_L(0); PG8_MMA(1, 0, At, B0); PG8_BAR; PG8_SCHED;
            PG8_STAGE(PG8_SB(0, 1), b2 + hstep, voffB);
            PG8_WAIT_V(6); PG8_BAR; PG8_MMA(1, 1, At, B1); PG8_BAR;
            PG8_LDB(B0, 1, 0); PG8_SCHED; PG8_LDA(At, 1, 0); PG8_STAGE(PG8_SA(0, 1), a2 + hstep, voffA);
            PG8_WAIT_L(8); PG8_BAR; PG8_WAIT_L(0); PG8_MMA(0, 0, At, B0); PG8_BAR; PG8_SCHED;
            PG8_LDB(B1, 1, 1); PG8_STAGE(PG8_SB(1, 0), b3, voffB);
            PG8_BAR; PG8_WAIT_L(0); PG8_MMA(0, 1, At, B1); PG8_BAR;
            PG8_LDA(At, 1, 1); PG8_STAGE(PG8_SA(1, 0), a3, voffA);
            PG8_BAR; PG8_WAIT_L(0); PG8_MMA(1, 0, At, B0); PG8_BAR; PG8_SCHED;
            PG8_STAGE(PG8_SB(1, 1), b3 + hstep, voffB);
            PG8_WAIT_V(6); PG8_BAR; PG8_MMA(1, 1, At, B1); PG8_BAR;
        }
        PG8_STAMP();
        if constexpr (!Epi::AFTER_DRAIN) { E(acc, cur, wr, wc, fr, fq); S.done(cur); }
        PG8_STAMP();
        if (!has_next) break;
#pragma unroll
        for (int a = 0; a < 2; ++a)
#pragma unroll
            for (int b = 0; b < 2; ++b)
#pragma unroll
                for (int m = 0; m < 4; ++m)
#pragma unroll
                    for (int n = 0; n < 2; ++n) acc[a][b][m][n] = (f32x4){0.f, 0.f, 0.f, 0.f};
        cur = nxt; cA = nA; cB = nB; ++ui;
    }
    PG8_WAIT_V(0);
    if (wr == 0) PG8_BAR;
    PG8_BAR;
    if constexpr (Epi::AFTER_DRAIN) { E.fused(acc, cur, wr, wc, fr, fq, lds, wid, lane); S.done(cur); }
    PG8_STAMP();
    if (STAMP && wid == 0) { stamps[lane] = lane < nts ? (((unsigned long long)(unsigned)ts_hi << 32) | (unsigned)ts_lo) : 0ull;
        if (lane == 62) stamps[62] = rt_entry; if (lane == 63) stamps[63] = (unsigned long long)wall_clock64(); }
#undef PG8_STAMP
#undef PG8_SA
#undef PG8_SB
#undef PG8_STAGE
#undef PG8_LDA
#undef PG8_LDB
#undef PG8_MMA
#undef PG8_WAIT_V
#undef PG8_WAIT_L
#undef PG8_BAR
#undef PG8_SCHED
}
}
typedef unsigned short bf16_t;
typedef short bf16x8 __attribute__((ext_vector_type(8)));
typedef float f32x4 __attribute__((ext_vector_type(4)));
typedef float f32x16 __attribute__((ext_vector_type(16)));
typedef unsigned u32x4 __attribute__((ext_vector_type(4)));
typedef unsigned u32x2 __attribute__((ext_vector_type(2)));
#define LAS __attribute__((address_space(3)))

constexpr int Bz = 4, S = 2048, DM = 2048, M = Bz * S, NH = 16, HD = 128, NKV = 4, WIDTH = 2048;
constexpr int NCMP = 127;
constexpr float SCALE = 0.08838834764831845f;
constexpr float DN_ALPHA = 1.6817928305074292f;
constexpr float LN_EPS = 1e-5f;
constexpr float NEG_INF = -1e30f;
__device__ __constant__ int LDH_[4] = {7168, 5120, 8192, 8192};

constexpr size_t al256(size_t x) { return (x + 255) & ~(size_t)255; }
constexpr size_t WS_WTIN0 = 0;
constexpr size_t WS_WTIN1 = WS_WTIN0 + (size_t)7168 * 2048 * 2;
constexpr size_t WS_WTIN2 = WS_WTIN1 + (size_t)5120 * 2048 * 2;
constexpr size_t WS_WTIN3 = WS_WTIN2 + (size_t)8192 * 2048 * 2;
constexpr size_t WS_WTOUT = WS_WTIN3 + (size_t)8192 * 2048 * 2;
constexpr size_t WS_WTSK  = WS_WTOUT + (size_t)4 * 2048 * 2048 * 2;
constexpr size_t WS_W1T   = WS_WTSK + (size_t)64 * 2048 * 2;
constexpr size_t WS_W2T   = WS_W1T + (size_t)2 * 128 * 4096 * 2;
constexpr size_t WS_C1    = WS_W2T + (size_t)2 * 128 * 128 * 2;
constexpr size_t WS_H     = al256(WS_C1 + 2 * 128 * 4);
constexpr size_t WS_XB    = WS_H + (size_t)M * 8192 * 2;
constexpr size_t WS_U     = WS_XB + (size_t)M * DM * 2;
constexpr size_t WS_GL    = WS_U + (size_t)M * WIDTH * 2;
constexpr size_t WS_FL    = WS_GL + (size_t)M * 48 * 4;
constexpr size_t WS_CF    = WS_FL + (size_t)M * 16 * 4;
constexpr size_t WS_KCMP  = WS_CF + (size_t)M * 16 * 4;
constexpr size_t WS_VCMP  = WS_KCMP + (size_t)Bz * 4 * 128 * 128 * 2;
constexpr size_t WS_SELM  = WS_VCMP + (size_t)Bz * 4 * 128 * 128 * 2;
constexpr size_t WS_END   = WS_SELM + (size_t)M * 4 * 4;

struct Args { const float* in[26]; float* out; unsigned char* ws; int ph_lo, ph_hi; };
static_assert(sizeof(Args) == 26 * 8 + 8 + 8 + 8, "no padding");

enum { I_X = 0, I_RELB = 1, I_WINA = 2, I_WOUTA = 3, I_LNGA = 4, I_LNBA = 5, I_PEK = 6, I_W1K = 7, I_W2K = 8, I_PEV = 9, I_W1V = 10, I_W2V = 11,
       I_WINB = 12, I_WOUTB = 13, I_LNGB = 14, I_LNBB = 15, I_SINKS = 16, I_WINC = 17, I_WOUTC = 18, I_LNGC = 19, I_LNBC = 20,
       I_WIND = 21, I_WOUTD = 22, I_LNGD = 23, I_LNBD = 24, I_FGB = 25 };

constexpr int LDS_MAIN = 131072, LDS_MISC = 8192, LDS_BYTES = LDS_MAIN + LDS_MISC;

__device__ __forceinline__ const float* gin(const Args& a, int idx) { asm volatile("" : "+s"(idx)); return a.in[idx]; }
__device__ __forceinline__ float bf2f(bf16_t v) { return __uint_as_float(((unsigned)v) << 16); }
__device__ __forceinline__ bf16_t f2bf(float f) { unsigned u = __float_as_uint(f); u += 0x7FFFu + ((u >> 16) & 1u); return (bf16_t)(u >> 16); }
__device__ __forceinline__ unsigned pk2(float lo, float hi) { return (unsigned)f2bf(lo) | ((unsigned)f2bf(hi) << 16); }
__device__ __forceinline__ float wsum(float v) { for (int o = 32; o > 0; o >>= 1) v += __shfl_xor(v, o); return v; }
__device__ __forceinline__ float wmax(float v) { for (int o = 32; o > 0; o >>= 1) v = fmaxf(v, __shfl_xor(v, o)); return v; }
__device__ __forceinline__ float silu_f(float x) { return x / (1.0f + __expf(-x)); }
__device__ __forceinline__ float sigmoid_f(float x) { return 1.0f / (1.0f + __expf(-x)); }
__device__ __forceinline__ float softplus_f(float x) { return fmaxf(x, 0.f) + log1pf(__expf(-fabsf(x))); }
__device__ __forceinline__ int rel_bucket(int dist) {
    dist = dist < 0 ? 0 : dist;
    if (dist < 16) return dist;
    const float ratio = (float)dist / 16.0f;
    int large = 16 + (int)(logf(ratio) / 2.0794415416798357f * 16.0f);
    return large < 31 ? large : 31;
}
__device__ __forceinline__ float dot2(const bf16_t* kp, int lane, float q0, float q1) {
    const unsigned w = *(const unsigned*)(kp + 2 * lane);
    return wsum(q0 * __uint_as_float(w << 16) + q1 * __uint_as_float(w & 0xffff0000u));
}
struct OAcc { float m, l, o0, o1; };
__device__ __forceinline__ void oacc_add(OAcc& a, float s, const bf16_t* vp, int lane) {
    const unsigned w = *(const unsigned*)(vp + 2 * lane);
    const float mn = fmaxf(a.m, s), al = __expf(a.m - mn), p = __expf(s - mn);
    a.l = a.l * al + p; a.o0 = a.o0 * al + p * __uint_as_float(w << 16); a.o1 = a.o1 * al + p * __uint_as_float(w & 0xffff0000u); a.m = mn;
}

struct CvtJob { const float* src; int ld, col0; bf16_t* dst; int nrows, K; };
constexpr int NJOBS = 16;
__device__ __forceinline__ CvtJob get_job(const Args& a, int j) {
    unsigned char* ws = a.ws;
    bf16_t* wtin[4] = {(bf16_t*)(ws + WS_WTIN0), (bf16_t*)(ws + WS_WTIN1), (bf16_t*)(ws + WS_WTIN2), (bf16_t*)(ws + WS_WTIN3)};
    bf16_t* wtout = (bf16_t*)(ws + WS_WTOUT); bf16_t* wtsk = (bf16_t*)(ws + WS_WTSK);
    switch (j) {
    case 0:  return CvtJob{gin(a, I_WINA), 7216, 0,    wtin[0], 5120, 2048};
    case 1:  return CvtJob{gin(a, I_WINA), 7216, 5168, wtin[0] + (size_t)5120 * 2048, 2048, 2048};
    case 2:  return CvtJob{gin(a, I_WINA), 7216, 5120, wtsk, 48, 2048};
    case 3:  return CvtJob{gin(a, I_WOUTA), 2048, 0,   wtout, 2048, 2048};
    case 4:  return CvtJob{gin(a, I_WINB), 5120, 0,    wtin[1], 5120, 2048};
    case 5:  return CvtJob{gin(a, I_WOUTB), 2048, 0,   wtout + (size_t)1 * 2048 * 2048, 2048, 2048};
    case 6:  return CvtJob{gin(a, I_WINC), 8192, 0,    wtin[2], 8192, 2048};
    case 7:  return CvtJob{gin(a, I_WOUTC), 2048, 0,   wtout + (size_t)2 * 2048 * 2048, 2048, 2048};
    case 8:  return CvtJob{gin(a, I_WIND), 8208, 0,    wtin[3], 6144, 2048};
    case 9:  return CvtJob{gin(a, I_WIND), 8208, 6160, wtin[3] + (size_t)6144 * 2048, 2048, 2048};
    case 10: return CvtJob{gin(a, I_WIND), 8208, 6144, wtsk + (size_t)48 * 2048, 16, 2048};
    case 11: return CvtJob{gin(a, I_WOUTD), 2048, 0,   wtout + (size_t)3 * 2048 * 2048, 2048, 2048};
    case 12: return CvtJob{gin(a, I_W1K), 128, 0, (bf16_t*)(ws + WS_W1T), 128, 4096};
    case 13: return CvtJob{gin(a, I_W1V), 128, 0, (bf16_t*)(ws + WS_W1T) + (size_t)128 * 4096, 128, 4096};
    case 14: return CvtJob{gin(a, I_W2K), 128, 0, (bf16_t*)(ws + WS_W2T), 128, 128};
    default: return CvtJob{gin(a, I_W2V), 128, 0, (bf16_t*)(ws + WS_W2T) + (size_t)128 * 128, 128, 128};
    }
}
__device__ __forceinline__ int job_tiles(const CvtJob& jb) { return (jb.K / 64) * ((jb.nrows + 63) / 64); }

__device__ __forceinline__ void phase_convert(const Args& a, unsigned char* lds) {
    int tid = threadIdx.x; asm volatile("" : "+v"(tid));
    float* tl = (float*)lds;
    int total = 0;
    for (int j = 0; j < NJOBS; ++j) total += job_tiles(get_job(a, j));
    for (int t = blockIdx.x; t < total; t += gridDim.x) {
        int j = 0, base = 0; CvtJob jb = get_job(a, 0);
        for (;;) { const int nt = job_tiles(jb); if (t < base + nt) break; base += nt; ++j; jb = get_job(a, j); }
        const int lt = t - base, nkt = jb.K / 64, tk = lt % nkt, tn = lt / nkt, k0 = tk * 64, n0 = tn * 64;
        { const int r = tid >> 4, c4 = (tid & 15) * 4;
#pragma unroll
          for (int ps = 0; ps < 2; ++ps) { const int k = r + 32 * ps;
              f32x4 v = {0.f, 0.f, 0.f, 0.f};
              if (n0 + c4 < jb.nrows) v = *(const f32x4*)(jb.src + (size_t)(k0 + k) * jb.ld + jb.col0 + n0 + c4);
              tl[k * 65 + c4 + 0] = v[0]; tl[k * 65 + c4 + 1] = v[1]; tl[k * 65 + c4 + 2] = v[2]; tl[k * 65 + c4 + 3] = v[3]; } }
        __syncthreads();
        { const int n = tid >> 3, k8 = (tid & 7) * 8;
          if (n0 + n < jb.nrows) { u32x4 w;
              w.x = pk2(tl[(k8 + 0) * 65 + n], tl[(k8 + 1) * 65 + n]); w.y = pk2(tl[(k8 + 2) * 65 + n], tl[(k8 + 3) * 65 + n]);
              w.z = pk2(tl[(k8 + 4) * 65 + n], tl[(k8 + 5) * 65 + n]); w.w = pk2(tl[(k8 + 6) * 65 + n], tl[(k8 + 7) * 65 + n]);
              *(u32x4*)(jb.dst + (size_t)(n0 + n) * jb.K + k0 + k8) = w; } }
        __syncthreads();
    }
    { const float* x = gin(a, I_X); bf16_t* xb = (bf16_t*)(a.ws + WS_XB);
      for (size_t i = (size_t)blockIdx.x * 512 + tid; i < (size_t)M * DM / 8; i += (size_t)gridDim.x * 512) {
          const f32x4 v0 = *(const f32x4*)(x + i * 8), v1 = *(const f32x4*)(x + i * 8 + 4);
          u32x4 w; w.x = pk2(v0[0], v0[1]); w.y = pk2(v0[2], v0[3]); w.z = pk2(v1[0], v1[1]); w.w = pk2(v1[2], v1[3]);
          *(u32x4*)(xb + i * 8) = w; } }
    if (blockIdx.x < 2) {
        const float* pe = gin(a, blockIdx.x == 0 ? I_PEK : I_PEV); const float* w1 = gin(a, blockIdx.x == 0 ? I_W1K : I_W1V);
        float* c1 = (float*)(a.ws + WS_C1) + blockIdx.x * 128;
        const int e = tid & 127, part = tid >> 7; float s = 0.f;
        for (int i = part * 1024; i < part * 1024 + 1024; ++i) s += pe[i] * w1[(size_t)i * 128 + e];
        tl[part * 128 + e] = s; __syncthreads();
        if (tid < 128) c1[tid] = tl[tid] + tl[128 + tid] + tl[256 + tid] + tl[384 + tid];
        __syncthreads();
    }
}

template <int NC>
__device__ __forceinline__ void skinny_gemm(const bf16_t* xb, const bf16_t* wsk, float* out) {
    int tid = threadIdx.x; asm volatile("" : "+v"(tid)); const int wid = tid >> 6, lane = tid & 63, r16 = lane & 15, kq = lane >> 4;
    for (int t = blockIdx.x * 8 + wid; t < M / 16; t += gridDim.x * 8) {
        f32x4 acc[NC];
#pragma unroll
        for (int c = 0; c < NC; ++c) acc[c] = (f32x4){0.f, 0.f, 0.f, 0.f};
        const bf16_t* ap = xb + (size_t)(t * 16 + r16) * DM + 8 * kq;
        const bf16_t* bp = wsk + (size_t)r16 * DM + 8 * kq;
        for (int k0 = 0; k0 < DM; k0 += 32) {
            const bf16x8 av = *(const bf16x8*)(ap + k0);
#pragma unroll
            for (int c = 0; c < NC; ++c) { const bf16x8 bv = *(const bf16x8*)(bp + (size_t)c * 16 * DM + k0);
                acc[c] = __builtin_amdgcn_mfma_f32_16x16x32_bf16(av, bv, acc[c], 0, 0, 0); }
        }
#pragma unroll
        for (int c = 0; c < NC; ++c)
#pragma unroll
            for (int j = 0; j < 4; ++j) out[(size_t)(t * 16 + kq * 4 + j) * (16 * NC) + c * 16 + r16] = acc[c][j];
    }
}

__device__ __forceinline__ void phase_ln(float* X, const float* g, const float* b, bf16_t* xb) {
    int tid = threadIdx.x; asm volatile("" : "+v"(tid)); const int wid = tid >> 6, lane = tid & 63;
    for (int row = blockIdx.x * 8 + wid; row < M; row += gridDim.x * 8) {
        f32x4* xr = (f32x4*)(X + (size_t)row * DM);
        f32x4 v[8]; float s = 0.f;
#pragma unroll
        for (int i = 0; i < 8; ++i) { v[i] = xr[lane + 64 * i]; s += (v[i][0] + v[i][1]) + (v[i][2] + v[i][3]); }
        const float mean = wsum(s) * (1.0f / DM);
        float q = 0.f;
#pragma unroll
        for (int i = 0; i < 8; ++i) { const f32x4 d = v[i] - mean; q += (d[0] * d[0] + d[1] * d[1]) + (d[2] * d[2] + d[3] * d[3]); }
        const float rstd = 1.0f / sqrtf(wsum(q) * (1.0f / DM) + LN_EPS);
#pragma unroll
        for (int i = 0; i < 8; ++i) { const int c = (lane + 64 * i);
            const f32x4 gg = ((const f32x4*)g)[c], bb = ((const f32x4*)b)[c];
            const f32x4 y = (v[i] - mean) * rstd * gg + bb;
            xr[c] = y;
            if (xb) { u32x2 w; w.x = pk2(y[0], y[1]); w.y = pk2(y[2], y[3]); *(u32x2*)(xb + (size_t)row * DM + c * 4) = w; } }
    }
}
__device__ __forceinline__ void naive_compress(const Args& a, unsigned char* lds) {
    int tid = threadIdx.x; asm volatile("" : "+v"(tid));
    float* blk = (float*)lds;
    float* red = blk + 4096;
    float* hid = red + 512;
    const bf16_t* H = (const bf16_t*)(a.ws + WS_H);
    for (int t = blockIdx.x; t < 2 * Bz * 128 * 4; t += gridDim.x) {
        const int kv = t & 1, g = (t >> 1) & 3, n = (t >> 3) & 127, b = t >> 10;
        bf16_t* out = (bf16_t*)(a.ws + (kv ? WS_VCMP : WS_KCMP)) + ((size_t)((b * 4 + g) * 128 + n)) * 128;
        if (n == 127) { if (tid < 128) out[tid] = 0; continue; }
        const float* pe = gin(a, kv ? I_PEV : I_PEK); const float* w1 = gin(a, kv ? I_W1V : I_W1K); const float* w2 = gin(a, kv ? I_W2V : I_W2K);
        const int col0 = (kv ? 2560 : 2048) + g * 128;
        for (int i = tid; i < 4096; i += 512) { const int l = i >> 7, d = i & 127;
            blk[i] = bf2f(H[(size_t)(b * S + 16 * n + l) * 7168 + col0 + d]) + pe[i]; }
        __syncthreads();
        { const int e = tid & 127, part = tid >> 7; float s = 0.f;
          for (int i = part * 1024; i < part * 1024 + 1024; ++i) s += blk[i] * w1[(size_t)i * 128 + e];
          red[part * 128 + e] = s; }
        __syncthreads();
        if (tid < 128) hid[tid] = silu_f(red[tid] + red[128 + tid] + red[256 + tid] + red[384 + tid]);
        __syncthreads();
        if (tid < 128) { float s = 0.f; for (int e = 0; e < 128; ++e) s += hid[e] * w2[e * 128 + tid]; out[tid] = f2bf(s); }
        __syncthreads();
    }
}

__device__ __forceinline__ void naive_nsa(const Args& a, unsigned char* lds) {
    int tid = threadIdx.x; asm volatile("" : "+v"(tid)); const int wid = tid >> 6, lane = tid & 63;
    float* ps = (float*)(lds + LDS_MAIN) + wid * 128;
    const bf16_t* H = (const bf16_t*)(a.ws + WS_H); const float* relb = gin(a, I_RELB);
    const bf16_t* KC = (const bf16_t*)(a.ws + WS_KCMP); const bf16_t* VC = (const bf16_t*)(a.ws + WS_VCMP);
    const float* GL = (const float*)(a.ws + WS_GL); bf16_t* U = (bf16_t*)(a.ws + WS_U);
    unsigned* SELM = (unsigned*)(a.ws + WS_SELM);
    constexpr int LD = 7168;
    for (int t = blockIdx.x * 8 + wid; t < M * 4; t += gridDim.x * 8) {
        const int row = t >> 2, g = t & 3, b = row / S, s = row % S;
        const bf16_t* hrow = H + (size_t)row * LD;
        int nv = s >= 31 ? (s - 31) / 16 + 1 : 0; if (nv > NCMP) nv = NCMP;
        const bf16_t* kc = KC + (size_t)(b * 4 + g) * 128 * 128; const bf16_t* vc = VC + (size_t)(b * 4 + g) * 128 * 128;
        float psum0 = 0.f, psum1 = 0.f; float oc[4][2];
#pragma unroll
        for (int hh = 0; hh < 4; ++hh) {
            const int head = g * 4 + hh;
            const unsigned qw = *(const unsigned*)(hrow + head * 128 + 2 * lane);
            const float q0 = __uint_as_float(qw << 16), q1 = __uint_as_float(qw & 0xffff0000u);
            float sc0 = NEG_INF, sc1 = NEG_INF;
            for (int n = 0; n < nv; ++n) {
                const float d = dot2(kc + n * 128, lane, q0, q1) * SCALE + relb[rel_bucket(s - (16 * n + 31)) * 16 + head];
                if (lane == (n & 63)) { if (n < 64) sc0 = d; else sc1 = d; }
            }
            const float mx = wmax(fmaxf(sc0, sc1));
            float p0 = (lane < nv) ? __expf(sc0 - mx) : 0.f, p1 = (lane + 64 < nv) ? __expf(sc1 - mx) : 0.f;
            const float den = wsum(p0 + p1), inv = 1.0f / fmaxf(den, 1e-30f);
            p0 *= inv; p1 *= inv; psum0 += p0; psum1 += p1;
            float o0 = 0.f, o1 = 0.f;
            for (int n = 0; n < nv; ++n) { const float pn = __shfl(n < 64 ? p0 : p1, n & 63);
                const unsigned w = *(const unsigned*)(vc + n * 128 + 2 * lane);
                o0 += pn * __uint_as_float(w << 16); o1 += pn * __uint_as_float(w & 0xffff0000u); }
            oc[hh][0] = o0; oc[hh][1] = o1;
        }
        ps[lane] = psum0; ps[64 + lane] = psum1;
        asm volatile("s_waitcnt lgkmcnt(0)" ::: "memory"); __builtin_amdgcn_wave_barrier();
        float val = -3e38f;
        if (lane < 32) { const int j = lane;
            const float imp = ps[4 * j] + ps[4 * j + 1] + ps[4 * j + 2] + 0.5f * ps[4 * j + 3] + (j > 0 ? 0.5f * ps[4 * j - 1] : 0.f);
            const int cur = s >> 6; const bool allowed = j <= cur, forced = allowed && (j == 0 || j == cur || j == cur - 1);
            val = forced ? 1e4f : (allowed ? imp : NEG_INF); }
        __builtin_amdgcn_wave_barrier();
        unsigned sel = 0;
        for (int r = 0; r < 8; ++r) { const float mx = wmax(val); const unsigned long long bal = __ballot(val == mx); const int j = __ffsll((long long)bal) - 1;
            if (mx > -5e29f) sel |= 1u << j; if (lane == j) val = -3e38f; }
        if (lane == 0) SELM[row * 4 + g] = sel;
#pragma unroll
        for (int hh = 0; hh < 4; ++hh) {
            const int head = g * 4 + hh;
            const unsigned qw = *(const unsigned*)(hrow + head * 128 + 2 * lane);
            const float q0 = __uint_as_float(qw << 16), q1 = __uint_as_float(qw & 0xffff0000u);
            OAcc as{NEG_INF, 0.f, 0.f, 0.f};
            for (int j = 0; j < 32; ++j) if ((sel >> j) & 1u) {
                const int kend = (64 * j + 63 < s) ? 64 * j + 63 : s;
                for (int key = 64 * j; key <= kend; ++key) { const bf16_t* kr = H + (size_t)(b * S + key) * LD;
                    const float sc = dot2(kr + 3072 + g * 128, lane, q0, q1) * SCALE + relb[rel_bucket(s - key) * 16 + head];
                    oacc_add(as, sc, kr + 3584 + g * 128, lane); } }
            OAcc aw{NEG_INF, 0.f, 0.f, 0.f};
            for (int key = (s - 511 > 0 ? s - 511 : 0); key <= s; ++key) { const bf16_t* kr = H + (size_t)(b * S + key) * LD;
                const float sc = dot2(kr + 4096 + g * 128, lane, q0, q1) * SCALE + relb[rel_bucket(s - key) * 16 + head];
                oacc_add(aw, sc, kr + 4608 + g * 128, lane); }
            const float is = 1.0f / fmaxf(as.l, 1e-30f), iw = 1.0f / fmaxf(aw.l, 1e-30f);
            const float g0 = sigmoid_f(GL[(size_t)row * 48 + head * 3 + 0]), g1 = sigmoid_f(GL[(size_t)row * 48 + head * 3 + 1]), g2 = sigmoid_f(GL[(size_t)row * 48 + head * 3 + 2]);
            const float o0 = g0 * oc[hh][0] + g1 * as.o0 * is + g2 * aw.o0 * iw, o1 = g0 * oc[hh][1] + g1 * as.o1 * is + g2 * aw.o1 * iw;
            const unsigned zw = *(const unsigned*)(hrow + 5120 + head * 128 + 2 * lane);
            *(unsigned*)(U + (size_t)row * WIDTH + head * 128 + 2 * lane) = pk2(o0 * silu_f(__uint_as_float(zw << 16)), o1 * silu_f(__uint_as_float(zw & 0xffff0000u)));
        }
    }
}

__device__ __forceinline__ void naive_swa(const Args& a) {
    int tid = threadIdx.x; asm volatile("" : "+v"(tid)); const int wid = tid >> 6, lane = tid & 63;
    const bf16_t* H = (const bf16_t*)(a.ws + WS_H); const float* relb = gin(a, I_RELB); const float* sinks = gin(a, I_SINKS); bf16_t* U = (bf16_t*)(a.ws + WS_U);
    constexpr int LD = 5120;
    for (int t = blockIdx.x * 8 + wid; t < M * NH; t += gridDim.x * 8) {
        const int row = t >> 4, head = t & 15, g = head >> 2, b = row / S, s = row % S;
        const bf16_t* hrow = H + (size_t)row * LD;
        const unsigned qw = *(const unsigned*)(hrow + head * 128 + 2 * lane);
        const float q0 = __uint_as_float(qw << 16), q1 = __uint_as_float(qw & 0xffff0000u);
        OAcc ac{sinks[head], 1.f, 0.f, 0.f};
        for (int key = (s - 127 > 0 ? s - 127 : 0); key <= s; ++key) { const bf16_t* kr = H + (size_t)(b * S + key) * LD;
            const float sc = dot2(kr + 2048 + g * 128, lane, q0, q1) * SCALE + relb[rel_bucket(s - key) * 16 + head];
            oacc_add(ac, sc, kr + 2560 + g * 128, lane); }
        const float il = 1.0f / fmaxf(ac.l, 1e-30f);
        const unsigned zw = *(const unsigned*)(hrow + 3072 + head * 128 + 2 * lane);
        *(unsigned*)(U + (size_t)row * WIDTH + head * 128 + 2 * lane) = pk2(ac.o0 * il * silu_f(__uint_as_float(zw << 16)), ac.o1 * il * silu_f(__uint_as_float(zw & 0xffff0000u)));
    }
}

__device__ __forceinline__ void naive_sb(const Args& a) {
    int tid = threadIdx.x; asm volatile("" : "+v"(tid)); const int wid = tid >> 6, lane = tid & 63;
    const bf16_t* H = (const bf16_t*)(a.ws + WS_H); bf16_t* U = (bf16_t*)(a.ws + WS_U);
    constexpr int LD = 8192;
    for (int t = blockIdx.x * 8 + wid; t < M * NH; t += gridDim.x * 8) {
        const int row = t >> 4, head = t & 15, b = row / S, s = row % S;
        const bf16_t* hrow = H + (size_t)row * LD;
        const unsigned qw = *(const unsigned*)(hrow + head * 128 + 2 * lane);
        const float q0 = __uint_as_float(qw << 16), q1 = __uint_as_float(qw & 0xffff0000u);
        float R = 0.f, o0 = 0.f, o1 = 0.f;
        for (int key = s - 1; key >= 0; --key) { const bf16_t* kr = H + (size_t)(b * S + key) * LD;
            const float z = dot2(kr + 2048 + head * 128, lane, q0, q1) * SCALE;
            const float L = -softplus_f(z);
            const float av = __expf(z + L + R);
            const unsigned w = *(const unsigned*)(kr + 4096 + head * 128 + 2 * lane);
            o0 += av * __uint_as_float(w << 16); o1 += av * __uint_as_float(w & 0xffff0000u);
            R += L; }
        const unsigned zw = *(const unsigned*)(hrow + 6144 + head * 128 + 2 * lane);
        *(unsigned*)(U + (size_t)row * WIDTH + head * 128 + 2 * lane) = pk2(o0 * silu_f(__uint_as_float(zw << 16)), o1 * silu_f(__uint_as_float(zw & 0xffff0000u)));
    }
}

__device__ __forceinline__ void fox_scan(const Args& a) {
    int tid = threadIdx.x; asm volatile("" : "+v"(tid)); const int wid = tid >> 6, lane = tid & 63;
    const float* FL = (const float*)(a.ws + WS_FL); float* CF = (float*)(a.ws + WS_CF); const float* fb = gin(a, I_FGB);
    for (int t = blockIdx.x * 8 + wid; t < Bz * NH; t += gridDim.x * 8) {
        const int b = t >> 4, h = t & 15; float carry = 0.f;
        for (int c = 0; c < S / 64; ++c) { const int s = c * 64 + lane;
            const float x = FL[(size_t)(b * S + s) * 16 + h] + fb[h];
            float v = -softplus_f(-x);
            for (int o = 1; o < 64; o <<= 1) { const float u = __shfl_up(v, o); if (lane >= o) v += u; }
            v += carry; CF[(size_t)(b * 16 + h) * S + s] = v; carry = __shfl(v, 63); }
    }
}
__device__ __forceinline__ void naive_fox(const Args& a) {
    int tid = threadIdx.x; asm volatile("" : "+v"(tid)); const int wid = tid >> 6, lane = tid & 63;
    const bf16_t* H = (const bf16_t*)(a.ws + WS_H); bf16_t* U = (bf16_t*)(a.ws + WS_U); const float* CF = (const float*)(a.ws + WS_CF);
    constexpr int LD = 8192;
    for (int t = blockIdx.x * 8 + wid; t < M * NH; t += gridDim.x * 8) {
        const int row = t >> 4, head = t & 15, b = row / S, s = row % S;
        const bf16_t* hrow = H + (size_t)row * LD; const float* cf = CF + (size_t)(b * 16 + head) * S;
        const unsigned qw = *(const unsigned*)(hrow + head * 128 + 2 * lane);
        const float q0 = __uint_as_float(qw << 16), q1 = __uint_as_float(qw & 0xffff0000u);
        const float ct = cf[s];
        OAcc ac{NEG_INF, 0.f, 0.f, 0.f};
        for (int key = 0; key <= s; ++key) { const bf16_t* kr = H + (size_t)(b * S + key) * LD;
            const float sc = dot2(kr + 2048 + head * 128, lane, q0, q1) * SCALE + (ct - cf[key]);
            oacc_add(ac, sc, kr + 4096 + head * 128, lane); }
        const float il = 1.0f / fmaxf(ac.l, 1e-30f);
        const unsigned zw = *(const unsigned*)(hrow + 6144 + head * 128 + 2 * lane);
        *(unsigned*)(U + (size_t)row * WIDTH + head * 128 + 2 * lane) = pk2(ac.o0 * il * silu_f(__uint_as_float(zw << 16)), ac.o1 * il * silu_f(__uint_as_float(zw & 0xffff0000u)));
    }
}
namespace fa {
typedef short s16x4 __attribute__((ext_vector_type(4)));
constexpr int SHM = 16384;
constexpr int OFF_V = 0, OFF_K = 2 * SHM, OFF_X = 4 * SHM;
constexpr int OFF_TAB = OFF_X + 2048;
constexpr int OFF_BIG = OFF_TAB + 4 * 132 * 4 + 192;
constexpr float LOG2E = 1.4426950408889634f;
constexpr float C2 = LOG2E * SCALE;
#define KSWZ(row, colB) ((row) * 256 + ((colB) ^ (((row) & 7) << 4)))
#define SBAR() __builtin_amdgcn_sched_barrier(0)
__device__ __forceinline__ int v_st(int k, int c) { const int kk = (k & ~0xC) | ((k & 4) << 1) | ((k & 8) >> 1); return ((kk >> 3) * 4 + (c >> 5)) * 512 + ((kk & 7) * 32 + (c & 31)) * 2; }
__device__ __forceinline__ int v_rd_base(int lane) { return ((lane & 3) << 3) | (((lane >> 2) & 3) << 6) | (((lane >> 4) & 1) << 5) | (((lane >> 5) & 1) << 8); }
constexpr int v_rd_off(int d0, int ks, int half) { return d0 * 512 + ks * 4096 + half * 2048; }
__device__ __forceinline__ constexpr int crow(int r, int hi) { return (r & 3) + 8 * (r >> 2) + 4 * hi; }
__device__ __forceinline__ unsigned cvtpk(float lo, float hi) { unsigned r; asm volatile("v_cvt_pk_bf16_f32 %0, %1, %2" : "=v"(r) : "v"(lo), "v"(hi)); return r; }
__device__ __forceinline__ float swap_other(float x) { auto rr = __builtin_amdgcn_permlane32_swap(__float_as_uint(x), __float_as_uint(x), false, false); return __uint_as_float((threadIdx.x & 32) ? rr[0] : rr[1]); }

template <int KB>
__device__ __forceinline__ void qkt(f32x16& p0, f32x16& p1, const LAS char* K_lds, int r32, int hi, const bf16x8* qr) {
    p0 = f32x16{}; p1 = f32x16{};
    const LAS char* kb[4];
#pragma unroll
    for (int dd = 0; dd < 4; ++dd) kb[dd] = K_lds + KB * SHM + KSWZ(r32, (dd * 16 + hi * 8) * 2);
#pragma unroll
    for (int d0 = 0; d0 < 8; ++d0) { const LAS char* a = kb[d0 & 3] + (d0 >> 2) * 128;
        bf16x8 b0 = *reinterpret_cast<const LAS bf16x8*>(a);
        bf16x8 b1 = *reinterpret_cast<const LAS bf16x8*>(a + 32 * 256);
        p0 = __builtin_amdgcn_mfma_f32_32x32x16_bf16(b0, qr[d0], p0, 0, 0, 0);
        p1 = __builtin_amdgcn_mfma_f32_32x32x16_bf16(b1, qr[d0], p1, 0, 0, 0); }
}
template <int VB>
__device__ __forceinline__ void pv_tile(f32x16* o, int vb0, bf16x8 pa0, bf16x8 pa1, bf16x8 pa2, bf16x8 pa3) {
#define TRRD(dst, off) asm volatile("ds_read_b64_tr_b16 %0, %1 offset:%2" : "=&v"(dst) : "v"(vb0), "i"(off) : "memory")
#define PV_D0(d0) do { s16x4 l0, l1, l2, l3, h0, h1, h2, h3; constexpr int b_ = VB * SHM + v_rd_off(d0, 0, 0); \
        TRRD(l0, b_); TRRD(h0, b_ + 2048); TRRD(l1, b_ + 4096); TRRD(h1, b_ + 6144); TRRD(l2, b_ + 8192); TRRD(h2, b_ + 10240); TRRD(l3, b_ + 12288); TRRD(h3, b_ + 14336); \
        asm volatile("s_waitcnt lgkmcnt(0)" ::: "memory"); SBAR(); \
        o[d0] = __builtin_amdgcn_mfma_f32_32x32x16_bf16(pa0, (bf16x8){l0[0], l0[1], l0[2], l0[3], h0[0], h0[1], h0[2], h0[3]}, o[d0], 0, 0, 0);   \
        o[d0] = __builtin_amdgcn_mfma_f32_32x32x16_bf16(pa1, (bf16x8){l1[0], l1[1], l1[2], l1[3], h1[0], h1[1], h1[2], h1[3]}, o[d0], 0, 0, 0);   \
        o[d0] = __builtin_amdgcn_mfma_f32_32x32x16_bf16(pa2, (bf16x8){l2[0], l2[1], l2[2], l2[3], h2[0], h2[1], h2[2], h2[3]}, o[d0], 0, 0, 0);   \
        o[d0] = __builtin_amdgcn_mfma_f32_32x32x16_bf16(pa3, (bf16x8){l3[0], l3[1], l3[2], l3[3], h3[0], h3[1], h3[2], h3[3]}, o[d0], 0, 0, 0); } while (0)
    PV_D0(0); PV_D0(1); PV_D0(2); PV_D0(3);
#undef PV_D0
#undef TRRD
}
__device__ __forceinline__ void pack_p(const f32x16& p0, const f32x16& p1, bf16x8& pa0, bf16x8& pa1, bf16x8& pa2, bf16x8& pa3) {
#define PK4(P, B_, OUT) do { unsigned a0 = cvtpk(P[B_+0], P[B_+1]), a1 = cvtpk(P[B_+2], P[B_+3]);                          \
        unsigned b0 = cvtpk(P[B_+4], P[B_+5]), b1 = cvtpk(P[B_+6], P[B_+7]);                                             \
        auto r0 = __builtin_amdgcn_permlane32_swap(a0, b0, false, false); auto r1 = __builtin_amdgcn_permlane32_swap(a1, b1, false, false); \
        u32x4 w = {r0[0], r1[0], r0[1], r1[1]}; OUT = *reinterpret_cast<bf16x8*>(&w); } while (0)
    PK4(p0, 0, pa0); PK4(p0, 8, pa1); PK4(p1, 0, pa2); PK4(p1, 8, pa3);
#undef PK4
}
struct Geo {
    int tid, wid, lane, r32, hi, vb0;
    LAS char* lds; LAS char* K_lds; LAS char* V_lds; LAS float* xch;
    __device__ __forceinline__ void init(unsigned char* lds_) {
        tid = threadIdx.x; asm volatile("" : "+v"(tid));
        wid = __builtin_amdgcn_readfirstlane(tid >> 6); lane = tid & 63; r32 = lane & 31; hi = lane >> 5;
        lds = (LAS char*)lds_; V_lds = lds + OFF_V; K_lds = lds + OFF_K; xch = (LAS float*)(lds + OFF_X) + wid * 64;
        vb0 = (int)(uintptr_t)V_lds + v_rd_base(lane);
    }
    __device__ __forceinline__ void relaunder() {
        asm volatile("" : "+v"(tid));
        lane = tid & 63; r32 = lane & 31; hi = lane >> 5; vb0 = (int)(uintptr_t)V_lds + v_rd_base(lane);
    }
};
struct Dma { unsigned koff[2], voff[2]; };
__device__ __forceinline__ void dma_init(Dma& D, const Geo& G, int ld) {
#pragma unroll
    for (int i = 0; i < 2; ++i) { const int P = (G.wid * 2 + i) * 64 + G.lane;
        { const int row = P >> 4, ch = (P & 15) ^ (row & 7); D.koff[i] = (unsigned)(row * ld + ch * 8) * 2u; }
        { const int st_ = P >> 5, w_ = P & 31, kk = (st_ >> 2) * 8 + (w_ >> 2), col = (st_ & 3) * 32 + (w_ & 3) * 8;
          const int key = (kk & ~0xC) | ((kk & 4) << 1) | ((kk & 8) >> 1); D.voff[i] = (unsigned)(key * ld + col) * 2u; } }
}
__device__ __forceinline__ void dma_tile(const Dma& D, const Geo& G, const bf16_t* Kp, const bf16_t* Vp, int ld, int kb, int bf) {
    const char* kg = (const char*)(Kp + (size_t)kb * ld); const char* vg = (const char*)(Vp + (size_t)kb * ld);
#pragma unroll
    for (int i = 0; i < 2; ++i) {
        __builtin_amdgcn_global_load_lds((const unsigned*)(kg + D.koff[i]), (LAS unsigned*)(G.K_lds + bf * SHM + (G.wid * 2 + i) * 1024), 16, 0, 0);
        __builtin_amdgcn_global_load_lds((const unsigned*)(vg + D.voff[i]), (LAS unsigned*)(G.V_lds + bf * SHM + (G.wid * 2 + i) * 1024), 16, 0, 0); }
}
#define VMW0() asm volatile("s_waitcnt vmcnt(0)" ::: "memory")
__device__ __forceinline__ void softmax_step(f32x16& p0, f32x16& p1, float& m, float& l, f32x16* o, const Geo& G) {
    float pmax = p0[0];
#pragma unroll
    for (int r = 1; r < 16; ++r) pmax = fmaxf(pmax, p0[r]);
#pragma unroll
    for (int r = 0; r < 16; ++r) pmax = fmaxf(pmax, p1[r]);
    pmax = fmaxf(pmax, swap_other(pmax));
    const float mn = fmaxf(m, pmax), alpha = __builtin_amdgcn_exp2f(m - mn);
    m = mn;
    float ps = 0.f;
#pragma unroll
    for (int r = 0; r < 16; ++r) { p0[r] = __builtin_amdgcn_exp2f(p0[r] - mn); ps += p0[r]; }
#pragma unroll
    for (int r = 0; r < 16; ++r) { p1[r] = __builtin_amdgcn_exp2f(p1[r] - mn); ps += p1[r]; }
    ps += swap_other(ps);
    l = l * alpha + ps;
    if (__any(alpha < 1.f)) {
        if (G.hi == 0) G.xch[G.r32] = alpha;
        asm volatile("s_waitcnt lgkmcnt(0)" ::: "memory");
#pragma unroll
        for (int r = 0; r < 16; ++r) { const float al = G.xch[crow(r, G.hi)];
#pragma unroll
            for (int d = 0; d < 4; ++d) o[d][r] *= al; }
        asm volatile("s_waitcnt lgkmcnt(0)" ::: "memory");
    }
}
__device__ __forceinline__ void fill_tab(LAS float* tab, const float* relb, int head, int i) { if (i <= 128) tab[i] = relb[rel_bucket(i) * 16 + head] * LOG2E; }

#define FA_STEP(t_, BUF, KBOF, ACT, PROCESS, BARRIER) do { const int kb_ = KBOF(t_);                       \
        if ((t_) + 1 < NT) dma_tile(D, G, Kp, Vp, ld, KBOF((t_) + 1), (BUF) ^ 1);                        \
        if (ACT(kb_)) { qkt<BUF>(p0, p1, G.K_lds, G.r32, G.hi, qr);                                      \
            PROCESS(kb_);                                                                               \
            { bf16x8 pa0, pa1, pa2, pa3; pack_p(p0, p1, pa0, pa1, pa2, pa3); pv_tile<BUF>(o, G.vb0, pa0, pa1, pa2, pa3); } } \
        VMW0(); BARRIER(t_); } while (0)
#define FA_LOOP(KBOF, ACT, PROCESS, BARRIER) do {                                                         \
        dma_tile(D, G, Kp, Vp, ld, KBOF(0), 0); VMW0(); __syncthreads();                                  \
        for (int t = 0; t < NT; t += 2) { FA_STEP(t, 0, KBOF, ACT, PROCESS, BARRIER); if (t + 1 < NT) FA_STEP(t + 1, 1, KBOF, ACT, PROCESS, BARRIER); } } while (0)
#define FA_ALWAYS(kb) true
#define FA_SYNC(t_) __syncthreads()

template <int W>
__device__ __forceinline__ void gqa_bias_mask(f32x16& p0, f32x16& p1, int qlo, int kb, const Geo& G, const LAS float* tab, unsigned selw_or_all) {
    const int dmin = qlo - kb - 63, dmax = qlo + 31 - kb;
    if (dmin >= 128 && dmax < W) {
        const float bf = tab[128];
#pragma unroll
        for (int r = 0; r < 16; ++r) { p0[r] = fmaf(p0[r], C2, bf); p1[r] = fmaf(p1[r], C2, bf); }
    } else {
        const int dq = qlo + G.r32 - kb - 4 * G.hi;
#pragma unroll
        for (int r = 0; r < 16; ++r) { const int c = (r & 3) + 8 * (r >> 2);
            const int d0 = dq - c, d1 = d0 - 32;
            const unsigned i0 = (unsigned)d0 < 128u ? (unsigned)d0 : 128u, i1 = (unsigned)d1 < 128u ? (unsigned)d1 : 128u;
            const float b0 = tab[i0], b1 = tab[i1];
            p0[r] = (unsigned)d0 < (unsigned)W ? fmaf(p0[r], C2, b0) : -__builtin_inff();
            p1[r] = (unsigned)d1 < (unsigned)W ? fmaf(p1[r], C2, b1) : -__builtin_inff(); }
    }
    if (!selw_or_all) {
#pragma unroll
        for (int r = 0; r < 16; ++r) { p0[r] = -__builtin_inff(); p1[r] = -__builtin_inff(); }
    }
}

__device__ __forceinline__ void fast_swa(const Args& a, unsigned char* lds_) {
    Geo G; G.init(lds_);
    const bf16_t* H = (const bf16_t*)(a.ws + WS_H); bf16_t* U = (bf16_t*)(a.ws + WS_U);
    const float* relb = gin(a, I_RELB); const float* sinks = gin(a, I_SINKS);
    constexpr int ld = 5120; Dma D; dma_init(D, G, ld);
    LAS float* tabs = (LAS float*)(G.lds + OFF_TAB);
    for (int item = blockIdx.x; item < Bz * 4 * 32; item += gridDim.x) {
        const int b = item >> 7, g = (item >> 5) & 3, c = item & 31, q0 = 64 * c;
        const int hh = G.wid & 3, head = 4 * g + hh, qlo = q0 + 32 * (G.wid >> 2);
        for (int i = G.tid; i < 4 * 132; i += 512) { const int th = i / 132, d = i - th * 132; fill_tab(tabs + th * 132, relb, 4 * g + th, d); }
        const LAS float* tab = tabs + hh * 132;
        const bf16_t* Kp = H + (size_t)b * S * ld + 2048 + g * 128; const bf16_t* Vp = H + (size_t)b * S * ld + 2560 + g * 128;
        bf16x8 qr[8];
        { const bf16_t* qp = H + (size_t)(b * S + qlo + G.r32) * ld + head * 128 + G.hi * 8;
#pragma unroll
          for (int d0 = 0; d0 < 8; ++d0) qr[d0] = *(const bf16x8*)(qp + d0 * 16); }
        const int j_lo = (q0 - 127 > 0 ? q0 - 127 : 0) >> 6, NT = c + 1 - j_lo;
        float m = sinks[head] * LOG2E, l = 1.f; f32x16 o[4] = {}; f32x16 p0, p1;
#define KBOF(t) ((j_lo + (t)) * 64)
#define PROC(kb) do { gqa_bias_mask<128>(p0, p1, qlo, kb, G, tab, 1u); softmax_step(p0, p1, m, l, o, G); } while (0)
        FA_LOOP(KBOF, FA_ALWAYS, PROC, FA_SYNC);
#undef PROC
#undef KBOF
        if (G.hi == 0) G.xch[G.r32] = 1.0f / l;
        asm volatile("s_waitcnt lgkmcnt(0)" ::: "memory");
#pragma unroll
        for (int r = 0; r < 16; ++r) { const int ql = crow(r, G.hi); const float il = G.xch[ql];
            const size_t row = (size_t)(b * S + qlo + ql);
#pragma unroll
            for (int d0 = 0; d0 < 4; ++d0) { const int col = head * 128 + d0 * 32 + G.r32;
                const float z = bf2f(H[row * ld + 3072 + col]);
                const float v = o[d0][r] * il * silu_f(z), vn = __shfl_xor(v, 1);
                if ((G.r32 & 1) == 0) *(unsigned*)(U + row * WIDTH + col) = cvtpk(v, vn); } }
        __syncthreads();
    }
}

__device__ __forceinline__ void fast_fox(const Args& a, unsigned char* lds_) {
    Geo G; G.init(lds_);
    const bf16_t* H = (const bf16_t*)(a.ws + WS_H); bf16_t* U = (bf16_t*)(a.ws + WS_U); const float* CF = (const float*)(a.ws + WS_CF);
    constexpr int ld = 8192; Dma D; dma_init(D, G, ld);
    LAS float* c2 = (LAS float*)(G.lds + OFF_BIG);
    for (int item2 = blockIdx.x; item2 < Bz * NH * 8; item2 += gridDim.x) {
        const int item = item2 & 255, pass = item2 >> 8;
        const int b = item >> 6, head = (item >> 2) & 15, pr = item & 3;
        const bf16_t* Kp = H + (size_t)b * S * ld + 2048 + head * 128; const bf16_t* Vp = H + (size_t)b * S * ld + 4096 + head * 128;
        { const float* cf = CF + (size_t)(b * 16 + head) * S; for (int i = G.tid; i < S; i += 512) c2[i] = cf[i] * LOG2E; }
        __syncthreads();
        {
            const int qb = pass == 0 ? 7 - pr : pr, qlo = qb * 256 + 32 * G.wid;
            bf16x8 qr[8];
            { const bf16_t* qp = H + (size_t)(b * S + qlo + G.r32) * ld + head * 128 + G.hi * 8;
#pragma unroll
              for (int d0 = 0; d0 < 8; ++d0) qr[d0] = *(const bf16x8*)(qp + d0 * 16); }
            const float cq = c2[qlo + G.r32];
            int NT = 4 * (qb + 1);
            float m = NEG_INF, l = 0.f; f32x16 o[4] = {}; f32x16 p0, p1;
#define KBOF(t) ((t) * 64)
#define ACT(kb) ((kb) <= qlo + 31)
#define PROC(kb) do { const LAS float* ck_ = c2 + (kb) + 4 * G.hi;                                              \
            _Pragma("unroll") for (int q4 = 0; q4 < 4; ++q4) { const f32x4 k0_ = *(const LAS f32x4*)(ck_ + 8 * q4), k1_ = *(const LAS f32x4*)(ck_ + 32 + 8 * q4); \
                _Pragma("unroll") for (int j = 0; j < 4; ++j) { p0[4 * q4 + j] = fmaf(p0[4 * q4 + j], C2, cq - k0_[j]); p1[4 * q4 + j] = fmaf(p1[4 * q4 + j], C2, cq - k1_[j]); } } \
            if ((kb) + 63 > qlo) { const int dq = qlo + G.r32 - (kb) - 4 * G.hi;                                 \
                _Pragma("unroll") for (int r = 0; r < 16; ++r) { const int c_ = (r & 3) + 8 * (r >> 2);         \
                    if (dq - c_ < 0) p0[r] = -__builtin_inff(); if (dq - c_ - 32 < 0) p1[r] = -__builtin_inff(); } } \
            softmax_step(p0, p1, m, l, o, G); } while (0)
            FA_LOOP(KBOF, ACT, PROC, FA_SYNC);
#undef PROC
#undef ACT
#undef KBOF
            if (G.hi == 0) G.xch[G.r32] = 1.0f / l;
            asm volatile("s_waitcnt lgkmcnt(0)" ::: "memory");
#pragma unroll
            for (int r = 0; r < 16; ++r) { const int ql = crow(r, G.hi); const float il = G.xch[ql];
                const size_t row = (size_t)(b * S + qlo + ql);
#pragma unroll
                for (int d0 = 0; d0 < 4; ++d0) { const int col = head * 128 + d0 * 32 + G.r32;
                    const float z = bf2f(H[row * ld + 6144 + col]);
                    const float v = o[d0][r] * il * silu_f(z), vn = __shfl_xor(v, 1);
                    if ((G.r32 & 1) == 0) *(unsigned*)(U + row * WIDTH + col) = cvtpk(v, vn); } }
            asm volatile("s_waitcnt lgkmcnt(0)" ::: "memory");
        }
        __syncthreads();
    }
}

__device__ __forceinline__ void fast_sb(const Args& a, unsigned char* lds_) {
    Geo G; G.init(lds_);
    const bf16_t* H = (const bf16_t*)(a.ws + WS_H); bf16_t* U = (bf16_t*)(a.ws + WS_U);
    constexpr int ld = 8192; Dma D; dma_init(D, G, ld);
    LAS int* flags = (LAS int*)(G.lds + OFF_BIG);
    for (int item2 = blockIdx.x; item2 < Bz * NH * 8; item2 += gridDim.x) {
        const int item = item2 & 255, pass = item2 >> 8;
        const int b = item >> 6, head = (item >> 2) & 15, pr = item & 3;
        const bf16_t* Kp = H + (size_t)b * S * ld + 2048 + head * 128; const bf16_t* Vp = H + (size_t)b * S * ld + 4096 + head * 128;
        {
            const int qb = pass == 0 ? 7 - pr : pr, qlo = qb * 256 + 32 * G.wid;
            bf16x8 qr[8];
            { const bf16_t* qp = H + (size_t)(b * S + qlo + G.r32) * ld + head * 128 + G.hi * 8;
#pragma unroll
              for (int d0 = 0; d0 < 8; ++d0) qr[d0] = *(const bf16x8*)(qp + d0 * 16); }
            int NT = 4 * (qb + 1); const int ntop = NT - 1;
            float Rp = 1.f; f32x16 o[4] = {}; f32x16 p0, p1;
#define KBOF(t) ((ntop - (t)) * 64)
#define ACT(kb) ((kb) < qlo + 31)
#define PROC(kb) do { const int dq = qlo + G.r32 - (kb) - 4 * G.hi; const bool diag = (kb) + 63 >= qlo;         \
            f32x16 k0_, k1_;                                                                                     \
            _Pragma("unroll") for (int r = 0; r < 16; ++r) { const int c_ = (r & 3) + 8 * (r >> 2);             \
                { const float z = p0[r] * SCALE, t_e = __builtin_amdgcn_exp2f(-fabsf(z) * LOG2E), rc = __builtin_amdgcn_rcpf(1.f + t_e), u_ = t_e * rc; \
                  float be = z >= 0.f ? rc : u_, ke = z >= 0.f ? u_ : rc; if (diag && dq - c_ < 1) { be = 0.f; ke = 1.f; } p0[r] = be; k0_[r] = ke; } \
                { const float z = p1[r] * SCALE, t_e = __builtin_amdgcn_exp2f(-fabsf(z) * LOG2E), rc = __builtin_amdgcn_rcpf(1.f + t_e), u_ = t_e * rc; \
                  float be = z >= 0.f ? rc : u_, ke = z >= 0.f ? u_ : rc; if (diag && dq - c_ - 32 < 1) { be = 0.f; ke = 1.f; } p1[r] = be; k1_[r] = ke; } } \
                                  \
            float sx[2][5];                                                                                      \
            sx[1][4] = 1.f;                                                                                      \
            _Pragma("unroll") for (int q4 = 3; q4 >= 0; --q4) sx[1][q4] = sx[1][q4 + 1] * ((k1_[4 * q4] * k1_[4 * q4 + 1]) * (k1_[4 * q4 + 2] * k1_[4 * q4 + 3])); \
            sx[0][4] = sx[1][0];                                                                                 \
            _Pragma("unroll") for (int q4 = 3; q4 >= 0; --q4) sx[0][q4] = sx[0][q4 + 1] * ((k0_[4 * q4] * k0_[4 * q4 + 1]) * (k0_[4 * q4 + 2] * k0_[4 * q4 + 3])); \
            _Pragma("unroll") for (int h2 = 1; h2 >= 0; --h2) _Pragma("unroll") for (int q4 = 3; q4 >= 0; --q4) { \
                auto rr = __builtin_amdgcn_permlane32_swap(__float_as_uint(sx[h2][q4]), __float_as_uint(sx[h2][q4 + 1]), false, false); \
                const float oth = __uint_as_float(G.hi ? rr[0] : rr[1]);                                        \
                float T = Rp * sx[h2][q4 + 1] * oth;                                                             \
                if (h2 == 1) { p1[4 * q4 + 3] *= T; T *= k1_[4 * q4 + 3]; p1[4 * q4 + 2] *= T; T *= k1_[4 * q4 + 2]; p1[4 * q4 + 1] *= T; T *= k1_[4 * q4 + 1]; p1[4 * q4] *= T; } \
                else         { p0[4 * q4 + 3] *= T; T *= k0_[4 * q4 + 3]; p0[4 * q4 + 2] *= T; T *= k0_[4 * q4 + 2]; p0[4 * q4 + 1] *= T; T *= k0_[4 * q4 + 1]; p0[4 * q4] *= T; } } \
            Rp = Rp * sx[0][0] * swap_other(sx[0][0]); } while (0)
#define SBBAR(t_) do { const int done_ = __all(Rp < 7.0e-31f) ? 1 : 0;                                         \
            if (G.lane == 0) flags[((t_) & 1) * 8 + G.wid] = done_;                                              \
            __syncthreads();                                                                                     \
            { const LAS int* f_ = flags + ((t_) & 1) * 8; const int all_ = f_[0] & f_[1] & f_[2] & f_[3] & f_[4] & f_[5] & f_[6] & f_[7]; \
              if (__builtin_amdgcn_readfirstlane(all_)) NT = (t_) + 1; } } while (0)
            FA_LOOP(KBOF, ACT, PROC, SBBAR);
#undef SBBAR
#undef PROC
#undef ACT
#undef KBOF
#pragma unroll
            for (int r = 0; r < 16; ++r) { const int ql = crow(r, G.hi);
                const size_t row = (size_t)(b * S + qlo + ql);
#pragma unroll
                for (int d0 = 0; d0 < 4; ++d0) { const int col = head * 128 + d0 * 32 + G.r32;
                    const float z = bf2f(H[row * ld + 6144 + col]);
                    const float v = o[d0][r] * silu_f(z), vn = __shfl_xor(v, 1);
                    if ((G.r32 & 1) == 0) *(unsigned*)(U + row * WIDTH + col) = cvtpk(v, vn); } }
            __syncthreads();
        }
    }
}

__device__ __forceinline__ void fast_compress(const Args& a, unsigned char* lds_) {
    Geo G; G.init(lds_);
    const bf16_t* H = (const bf16_t*)(a.ws + WS_H);
    LAS float* part = (LAS float*)G.lds;
    LAS bf16_t* hid = (LAS bf16_t*)(G.lds + LDS_MAIN);
    for (int t = blockIdx.x; t < 2 * Bz * 4 * 4; t += gridDim.x) {
        const int kv = t & 1, g = (t >> 1) & 3, nb = (t >> 3) & 3, b = t >> 5, n0 = nb * 32;
        const bf16_t* w1t = (const bf16_t*)(a.ws + WS_W1T) + (size_t)kv * 128 * 4096;
        const bf16_t* w2t = (const bf16_t*)(a.ws + WS_W2T) + (size_t)kv * 128 * 128;
        const float* c1 = (const float*)(a.ws + WS_C1) + kv * 128;
        bf16_t* out = (bf16_t*)(a.ws + (kv ? WS_VCMP : WS_KCMP)) + (size_t)(b * 4 + g) * 128 * 128;
        const int col0 = (kv ? 2560 : 2048) + g * 128;
        int n = n0 + G.r32; if (n > 126) n = 126;
        f32x16 acc[4] = {};
        for (int li = 0; li < 4; ++li) { const int l = G.wid * 4 + li;
            const bf16_t* ap = H + (size_t)(b * S + 16 * n + l) * 7168 + col0 + 8 * G.hi;
            const bf16_t* bp = w1t + (size_t)G.r32 * 4096 + l * 128 + 8 * G.hi;
#pragma unroll
            for (int ks = 0; ks < 8; ++ks) { const bf16x8 av = *(const bf16x8*)(ap + ks * 16);
#pragma unroll
                for (int cb = 0; cb < 4; ++cb) { const bf16x8 bv = *(const bf16x8*)(bp + (size_t)cb * 32 * 4096 + ks * 16);
                    acc[cb] = __builtin_amdgcn_mfma_f32_32x32x16_bf16(av, bv, acc[cb], 0, 0, 0); } } }
#pragma unroll
        for (int cb = 0; cb < 4; ++cb)
#pragma unroll
            for (int r = 0; r < 16; ++r) part[(G.wid * 32 + crow(r, G.hi)) * 128 + cb * 32 + G.r32] = acc[cb][r];
        __syncthreads();
        for (int i = G.tid; i < 32 * 128; i += 512) { float s = c1[i & 127];
#pragma unroll
            for (int w = 0; w < 8; ++w) s += part[w * 4096 + i];
            hid[i] = f2bf(silu_f(s)); }
        __syncthreads();
        if (G.wid < 4) { f32x16 o2 = {};
#pragma unroll
            for (int ks = 0; ks < 8; ++ks) { const bf16x8 av = *(const LAS bf16x8*)(hid + G.r32 * 128 + ks * 16 + 8 * G.hi);
                const bf16x8 bv = *(const bf16x8*)(w2t + (size_t)(G.wid * 32 + G.r32) * 128 + ks * 16 + 8 * G.hi);
                o2 = __builtin_amdgcn_mfma_f32_32x32x16_bf16(av, bv, o2, 0, 0, 0); }
#pragma unroll
            for (int r = 0; r < 16; ++r) { const int nn = n0 + crow(r, G.hi);
                out[(size_t)nn * 128 + G.wid * 32 + G.r32] = nn < 127 ? f2bf(o2[r]) : (bf16_t)0; } }
        __syncthreads();
    }
}

template <int MODE>
__device__ __forceinline__ void nsa_epi(const f32x16* o, float f, const Geo& G, float* Oscr, const bf16_t* H, bf16_t* U, int rowbase, int head) {
    if (G.hi == 0) G.xch[G.r32] = f;
    asm volatile("s_waitcnt lgkmcnt(0)" ::: "memory");
#pragma unroll
    for (int r = 0; r < 16; ++r) { const int ql = crow(r, G.hi); const float fr = G.xch[ql];
        const size_t row = (size_t)(rowbase + ql);
        float* op = Oscr + row * WIDTH + head * 128 + G.r32;
        float pv[4] = {0.f, 0.f, 0.f, 0.f}; float zv[4] = {0.f, 0.f, 0.f, 0.f};
        if (MODE >= 1) {
#pragma unroll
            for (int d0 = 0; d0 < 4; ++d0) pv[d0] = op[d0 * 32]; }
        if (MODE == 2) { const bf16_t* zp = H + row * 7168 + 5120 + head * 128 + G.r32;
#pragma unroll
            for (int d0 = 0; d0 < 4; ++d0) zv[d0] = bf2f(zp[d0 * 32]); }
#pragma unroll
        for (int d0 = 0; d0 < 4; ++d0) { const float v = o[d0][r] * fr + pv[d0];
            if (MODE < 2) op[d0 * 32] = v;
            else { const float uu = v * silu_f(zv[d0]), un = __shfl_xor(uu, 1);
                   if ((G.r32 & 1) == 0) *(unsigned*)(U + row * WIDTH + head * 128 + d0 * 32 + G.r32) = cvtpk(uu, un); } }
        asm volatile("" ::: "memory"); }
    asm volatile("s_waitcnt vmcnt(0) lgkmcnt(0)" ::: "memory");
}
__device__ __forceinline__ void cmp_bias_mask(f32x16& p0, f32x16& p1, int qlo, int kb, const Geo& G, const LAS float* tab) {
    const int dq = qlo + G.r32 - 31 - 16 * (kb + 4 * G.hi);
#pragma unroll
    for (int r = 0; r < 16; ++r) { const int c = (r & 3) + 8 * (r >> 2);
        const int d0 = dq - 16 * c, d1 = d0 - 512;
        const unsigned i0 = (unsigned)d0 < 128u ? (unsigned)d0 : 128u, i1 = (unsigned)d1 < 128u ? (unsigned)d1 : 128u;
        const float b0 = tab[i0], b1 = tab[i1];
        p0[r] = d0 >= 0 ? fmaf(p0[r], C2, b0) : -__builtin_inff();
        p1[r] = d1 >= 0 ? fmaf(p1[r], C2, b1) : -__builtin_inff(); }
}
__device__ __forceinline__ void softmax_stats(const f32x16& p0, const f32x16& p1, float& m, float& l) {
    float pmax = p0[0];
#pragma unroll
    for (int r = 1; r < 16; ++r) pmax = fmaxf(pmax, p0[r]);
#pragma unroll
    for (int r = 0; r < 16; ++r) pmax = fmaxf(pmax, p1[r]);
    pmax = fmaxf(pmax, swap_other(pmax));
    const float mn = fmaxf(m, pmax), alpha = __builtin_amdgcn_exp2f(m - mn);
    float ps = 0.f;
#pragma unroll
    for (int r = 0; r < 16; ++r) ps += __builtin_amdgcn_exp2f(p0[r] - mn) + __builtin_amdgcn_exp2f(p1[r] - mn);
    ps += swap_other(ps);
    l = l * alpha + ps; m = mn;
}
__device__ __forceinline__ void cmp_importance(const f32x16& p0, const f32x16& p1, float& carry, LAS float* imp_q, int jbase, const Geo& G) {
    float spill_prev = carry;
#pragma unroll
    for (int h2 = 0; h2 < 2; ++h2)
#pragma unroll
        for (int q4 = 0; q4 < 4; ++q4) {
            const float e0 = h2 ? p1[4 * q4] : p0[4 * q4], e1 = h2 ? p1[4 * q4 + 1] : p0[4 * q4 + 1], e2 = h2 ? p1[4 * q4 + 2] : p0[4 * q4 + 2], e3 = h2 ? p1[4 * q4 + 3] : p0[4 * q4 + 3];
            const float spill = 0.5f * e3, mainv = (e0 + e1) + (e2 + spill);
            auto rr = __builtin_amdgcn_permlane32_swap(__float_as_uint(spill_prev), __float_as_uint(spill), false, false);
            const float recv = __uint_as_float(G.hi ? rr[0] : rr[1]);
            imp_q[jbase + 8 * h2 + 2 * q4 + G.hi] = mainv + recv;
            spill_prev = spill; }
    carry = spill_prev;
}

__device__ __forceinline__ void fast_nsa(const Args& a, unsigned char* lds_) {
    Geo G; G.init(lds_);
    const bf16_t* H = (const bf16_t*)(a.ws + WS_H); bf16_t* U = (bf16_t*)(a.ws + WS_U);
    const float* relb = gin(a, I_RELB); const float* GL = (const float*)(a.ws + WS_GL); float* Oscr = a.out;
    const bf16_t* KC = (const bf16_t*)(a.ws + WS_KCMP); const bf16_t* VC = (const bf16_t*)(a.ws + WS_VCMP);
    LAS float* tabs = (LAS float*)(G.lds + OFF_TAB);
    LAS float* imp = (LAS float*)(G.lds + OFF_BIG);
    LAS unsigned* selw = (LAS unsigned*)(G.lds + OFF_BIG + 32768);
    LAS int* tlist = (LAS int*)(G.lds + OFF_BIG + 32768 + 256);
    for (int item2 = blockIdx.x; item2 < Bz * 4 * 32; item2 += gridDim.x) {
        const int idx = item2 & 255, pass = item2 >> 8;
        const int b = idx >> 6, g = (idx >> 4) & 3, cc = idx & 15, c = pass == 0 ? 31 - cc : cc, q0 = 64 * c;
        const int hh = G.wid & 3, head = 4 * g + hh, qlo = q0 + 32 * (G.wid >> 2), rowbase = b * S + qlo;
        for (int i = G.tid; i < 4 * 132; i += 512) { const int th = i / 132, d = i - th * 132; fill_tab(tabs + th * 132, relb, 4 * g + th, d); }
        if (G.tid < 64) selw[G.tid] = 0u;
        const LAS float* tab = tabs + hh * 132;
        bf16x8 qr[8];
        { const bf16_t* qp = H + (size_t)(rowbase + G.r32) * 7168 + head * 128 + G.hi * 8;
#pragma unroll
          for (int d0 = 0; d0 < 8; ++d0) qr[d0] = *(const bf16x8*)(qp + d0 * 16); }
        const float gl0 = GL[(size_t)(rowbase + G.r32) * 48 + head * 3 + 0], gl1 = GL[(size_t)(rowbase + G.r32) * 48 + head * 3 + 1], gl2 = GL[(size_t)(rowbase + G.r32) * 48 + head * 3 + 2];
        f32x16 p0, p1; f32x16 o[4];
        { Dma D; dma_init(D, G, 128);
          const bf16_t* Kp = KC + (size_t)(b * 4 + g) * 128 * 128; const bf16_t* Vp = VC + (size_t)(b * 4 + g) * 128 * 128;
          const bool two = (4 * c + 3) > 64;
          dma_tile(D, G, Kp, Vp, 128, 0, 0); if (two) dma_tile(D, G, Kp, Vp, 128, 64, 1);
          VMW0(); __syncthreads();
          float m = NEG_INF, l = 0.f;
          qkt<0>(p0, p1, G.K_lds, G.r32, G.hi, qr); cmp_bias_mask(p0, p1, qlo, 0, G, tab); softmax_stats(p0, p1, m, l);
          if (two) { qkt<1>(p0, p1, G.K_lds, G.r32, G.hi, qr); cmp_bias_mask(p0, p1, qlo, 64, G, tab); softmax_stats(p0, p1, m, l); }
          const float il2 = l > 0.f ? __builtin_log2f(1.0f / l) : 0.f;
          const float sh = m - il2;
#pragma unroll
          for (int d = 0; d < 4; ++d) o[d] = f32x16{};
          LAS float* imp_q = imp + (hh * 64 + 32 * (G.wid >> 2) + G.r32) * 32; float carry = 0.f;
          { qkt<0>(p0, p1, G.K_lds, G.r32, G.hi, qr); cmp_bias_mask(p0, p1, qlo, 0, G, tab);
#pragma unroll
            for (int r = 0; r < 16; ++r) { p0[r] = __builtin_amdgcn_exp2f(p0[r] - sh); p1[r] = __builtin_amdgcn_exp2f(p1[r] - sh); }
            cmp_importance(p0, p1, carry, imp_q, 0, G);
            bf16x8 pa0, pa1, pa2, pa3; pack_p(p0, p1, pa0, pa1, pa2, pa3); pv_tile<0>(o, G.vb0, pa0, pa1, pa2, pa3); }
          if (two) { qkt<1>(p0, p1, G.K_lds, G.r32, G.hi, qr); cmp_bias_mask(p0, p1, qlo, 64, G, tab);
#pragma unroll
            for (int r = 0; r < 16; ++r) { p0[r] = __builtin_amdgcn_exp2f(p0[r] - sh); p1[r] = __builtin_amdgcn_exp2f(p1[r] - sh); }
            cmp_importance(p0, p1, carry, imp_q, 16, G);
            bf16x8 pa0, pa1, pa2, pa3; pack_p(p0, p1, pa0, pa1, pa2, pa3); pv_tile<1>(o, G.vb0, pa0, pa1, pa2, pa3); }
          nsa_epi<0>(o, l > 0.f ? sigmoid_f(gl0) : 0.f, G, Oscr, H, U, rowbase, head);
        }
        __syncthreads(); G.relaunder();
        { const int qloc = G.tid >> 3, jg = G.tid & 7;
          float v[32];
#pragma unroll
          for (int k = 0; k < 8; ++k) { const LAS float* ip = imp + qloc * 32 + 4 * k;
              const f32x4 s4 = (*(const LAS f32x4*)ip + *(const LAS f32x4*)(ip + 2048)) + (*(const LAS f32x4*)(ip + 4096) + *(const LAS f32x4*)(ip + 6144));
#pragma unroll
              for (int i = 0; i < 4; ++i) { const int j = 4 * k + i; const bool allowed = j <= c, forced = allowed && (j == 0 || j == c || j == c - 1);
                  v[j] = forced ? 1e4f : (allowed ? s4[i] : NEG_INF); } }
          float mv[4] = {0.f, 0.f, 0.f, 0.f};
#pragma unroll
          for (int k = 0; k < 8; ++k) if (k == jg) { mv[0] = v[4 * k]; mv[1] = v[4 * k + 1]; mv[2] = v[4 * k + 2]; mv[3] = v[4 * k + 3]; }
          unsigned bits = 0u;
#pragma unroll
          for (int i = 0; i < 4; ++i) { const int myj = 4 * jg + i; int rank = 0;
#pragma unroll
              for (int j = 0; j < 32; ++j) rank += (v[j] > mv[i] || (v[j] == mv[i] && j < myj)) ? 1 : 0;
              if (rank < 8 && mv[i] > -5e29f) bits |= 1u << myj; }
          if (bits) atomicOr((unsigned*)(selw + qloc), bits);
        }
        __syncthreads();
        const unsigned sw = selw[32 * (G.wid >> 2) + G.r32];
        unsigned un = selw[G.lane];
#pragma unroll
        for (int off = 32; off > 0; off >>= 1) un |= (unsigned)__shfl_xor((int)un, off);
        un = __builtin_amdgcn_readfirstlane(un);
        if (G.tid < 32 && ((un >> G.tid) & 1u)) tlist[__builtin_popcount(un & ((1u << G.tid) - 1u))] = G.tid;
        __syncthreads();
        G.relaunder();
        Dma D; dma_init(D, G, 7168); constexpr int ld = 7168;
        { const bf16_t* Kp = H + (size_t)b * S * ld + 3072 + g * 128; const bf16_t* Vp = H + (size_t)b * S * ld + 3584 + g * 128;
          int NT = __builtin_popcount(un);
          float m = NEG_INF, l = 0.f;
#pragma unroll
          for (int d = 0; d < 4; ++d) o[d] = f32x16{};
#define KBOF(t) (tlist[t] * 64)
#define PROC(kb) do { gqa_bias_mask<0x40000000>(p0, p1, qlo, kb, G, tab, (sw >> ((kb) >> 6)) & 1u); softmax_step(p0, p1, m, l, o, G); } while (0)
          FA_LOOP(KBOF, FA_ALWAYS, PROC, FA_SYNC);
#undef PROC
#undef KBOF
          nsa_epi<1>(o, sigmoid_f(gl1) / l, G, Oscr, H, U, rowbase, head);
        }
        G.relaunder(); dma_init(D, G, 7168);
        { const bf16_t* Kp = H + (size_t)b * S * ld + 4096 + g * 128; const bf16_t* Vp = H + (size_t)b * S * ld + 4608 + g * 128;
          const int j_lo = (q0 - 511 > 0 ? q0 - 511 : 0) >> 6; int NT = c + 1 - j_lo;
          float m = NEG_INF, l = 0.f;
#pragma unroll
          for (int d = 0; d < 4; ++d) o[d] = f32x16{};
#define KBOF(t) ((j_lo + (t)) * 64)
#define PROC(kb) do { gqa_bias_mask<512>(p0, p1, qlo, kb, G, tab, 1u); softmax_step(p0, p1, m, l, o, G); } while (0)
          FA_LOOP(KBOF, FA_ALWAYS, PROC, FA_SYNC);
#undef PROC
#undef KBOF
          nsa_epi<2>(o, sigmoid_f(gl2) / l, G, Oscr, H, U, rowbase, head);
        }
        __syncthreads();
    }
}
#undef FA_STEP
#undef FA_LOOP
}
constexpr int NPH = 21;
__host__ __device__ inline bool phase_empty(int ph) { return ph == 7 || ph == 12; }
__device__ __forceinline__ int ldh_of(int layer) { return layer == 0 ? 7168 : (layer == 1 ? 5120 : 8192); }

__global__ void __launch_bounds__(512, 2) mega(Args a) {
    extern __shared__ __attribute__((aligned(16))) unsigned char lds[];
    cg::grid_group grid = cg::this_grid();
    unsigned char* ws = a.ws;
    bf16_t* H = (bf16_t*)(ws + WS_H); bf16_t* XB = (bf16_t*)(ws + WS_XB); bf16_t* U = (bf16_t*)(ws + WS_U);
    for (int ph = a.ph_lo; ph < a.ph_hi; ++ph) {
        if (phase_empty(ph)) continue;
        if (ph == 0) { phase_convert(a, lds); }
        else {
            const int layer = (ph - 1) / 5, k = (ph - 1) % 5;
            if (k == 0) {
                const size_t wo = layer == 0 ? WS_WTIN0 : (layer == 1 ? WS_WTIN1 : (layer == 2 ? WS_WTIN2 : WS_WTIN3));
                const int N = ldh_of(layer);
                pg8::Gemm g{XB, (const bf16_t*)(ws + wo), M, N, DM}; pg8::StaticOrder So; So.init(M, N, (int)gridDim.x, (int)blockIdx.x);
                pg8::EpiH E{H, N};
                pg8::gemm_phase<pg8::EpiH, pg8::StaticOrder, false>((PG8_LAS unsigned char*)lds, g, So, E, nullptr);
                if (layer == 0) skinny_gemm<3>(XB, (const bf16_t*)(ws + WS_WTSK), (float*)(ws + WS_GL));
                if (layer == 3) skinny_gemm<1>(XB, (const bf16_t*)(ws + WS_WTSK) + (size_t)48 * 2048, (float*)(ws + WS_FL));
            } else if (k == 1) {
                if (layer == 0) fa::fast_compress(a, lds);
                if (layer == 3) fox_scan(a);
            } else if (k == 2) {
                if (layer == 0) fa::fast_nsa(a, lds);
                else if (layer == 1) fa::fast_swa(a, lds);
                else if (layer == 2) fa::fast_sb(a, lds);
                else fa::fast_fox(a, lds);
            } else if (k == 3) {
                pg8::Gemm g{U, (const bf16_t*)(ws + WS_WTOUT) + (size_t)layer * 2048 * 2048, M, DM, WIDTH}; pg8::StaticOrder So; So.init(M, DM, (int)gridDim.x, (int)blockIdx.x);
                pg8::EpiRes E{a.out, layer == 0 ? gin(a, I_X) : a.out, DM, DN_ALPHA};
                pg8::gemm_phase<pg8::EpiRes, pg8::StaticOrder, false>((PG8_LAS unsigned char*)lds, g, So, E, nullptr);
            } else {
                const int ig = layer == 0 ? I_LNGA : (layer == 1 ? I_LNGB : (layer == 2 ? I_LNGC : I_LNGD));
                phase_ln(a.out, gin(a, ig), gin(a, ig + 1), layer < 3 ? XB : nullptr);
            }
        }
        bool more = false; for (int q = ph + 1; q < a.ph_hi; ++q) if (!phase_empty(q)) more = true;
        if (more) grid.sync();
    }
}

#ifndef MK_MULTI
#define MK_MULTI 0
#endif
extern "C" void kernel_launch(void* const* d_in, const int* in_sizes, int n_in, void* d_out, int out_size, void* d_ws, size_t ws_size, hipStream_t stream) {
    static int grid = 0;
    if (grid == 0) {
        if (n_in != 26 || out_size != M * DM || ws_size < WS_END) { fprintf(stderr, "kernel_launch: unexpected shapes: n_in %d out %d ws %zu (need %zu)\n", n_in, out_size, ws_size, (size_t)WS_END); grid = -1; return; }
        int dev = 0, cus = 0, per_cu = 0;
        hipGetDevice(&dev); hipDeviceGetAttribute(&cus, hipDeviceAttributeMultiprocessorCount, dev);
        if (hipFuncSetAttribute((const void*)mega, hipFuncAttributeMaxDynamicSharedMemorySize, LDS_BYTES) != hipSuccess) { fprintf(stderr, "kernel_launch: hipFuncSetAttribute failed\n"); grid = -1; return; }
        if (hipOccupancyMaxActiveBlocksPerMultiprocessor(&per_cu, (const void*)mega, 512, LDS_BYTES) != hipSuccess || per_cu < 1) { fprintf(stderr, "kernel_launch: occupancy query failed (%d)\n", per_cu); grid = -1; return; }
        grid = cus * 1;
        fprintf(stderr, "kernel_launch: cus %d per_cu %d grid %d ws %zu need %zu\n", cus, per_cu, grid, ws_size, (size_t)WS_END);
    }
    if (grid < 0) return;
    Args a{};
    for (int i = 0; i < 26; ++i) a.in[i] = (const float*)d_in[i];
    a.out = (float*)d_out; a.ws = (unsigned char*)d_ws;
#if MK_MULTI
    for (int ph = 0; ph < NPH; ++ph) {
        if (phase_empty(ph)) continue;
        a.ph_lo = ph; a.ph_hi = ph + 1;
        void* args[] = {&a};
        hipError_t e = hipLaunchCooperativeKernel((const void*)mega, dim3(grid), dim3(512), args, LDS_BYTES, stream);
        if (e != hipSuccess) { fprintf(stderr, "kernel_launch: launch of phase %d failed: %s\n", ph, hipGetErrorString(e)); break; }
    }
#else
    a.ph_lo = 0; a.ph_hi = NPH;
    void* args[] = {&a};
    hipError_t e = hipLaunchCooperativeKernel((const void*)mega, dim3(grid), dim3(512), args, LDS_BYTES, stream);
    if (e != hipSuccess) fprintf(stderr, "kernel_launch: cooperative launch failed: %s (grid %d)\n", hipGetErrorString(e), grid);
#endif
}
```
